# Optimizing an MI355X kernel written in HIP

```python
import jax, jax.numpy as jnp
from jax import lax
import numpy as np

D_MODEL = 1024
BATCH = 1
SEQ = 16384
DEPTH = 4

HEAD_DIM = 64
RW_WIDTH = 3 * D_MODEL // 8
RW_HEADS = RW_WIDTH // HEAD_DIM
RW_DECAY_LORA = 64
RW_AAA_LORA = 64
RW_MV_LORA = 32
RW_GATE_LORA = 128
RW_GN_EPS = 64e-5
HG_WIDTH = D_MODEL // 4
HG_HEADS = HG_WIDTH // HEAD_DIM
HG_EXPAND = 128
HG_FDIM = HG_HEADS * HG_EXPAND
HG_GATE_FLOOR = 1e-30
GL_WIDTH = D_MODEL - RW_WIDTH - HG_WIDTH
GL_HEADS = 4
GL_VAL_DIM = GL_WIDTH // GL_HEADS
GL_KEY_DIM = GL_VAL_DIM // 2
GL_KWIDTH = GL_HEADS * GL_KEY_DIM
GL_GATE_LORA = 16
GL_GATE_NORMALIZER = 16.0
GL_CONV_WIDTH = 4
GL_CONV_CH = 2 * GL_KWIDTH + GL_WIDTH
D_MIX = RW_WIDTH + HG_WIDTH + GL_WIDTH
D_FF = 2816
FFN_RESIDUAL_WEIGHT = 0.5
CHUNK = 16
NORM_EPS = 1e-5
L2_EPS = 1e-12

RW_SPLITS = (RW_WIDTH, RW_WIDTH, RW_WIDTH, RW_DECAY_LORA, RW_AAA_LORA, RW_GATE_LORA)
HG_SPLITS = (HG_FDIM, HG_FDIM, HG_WIDTH, HG_WIDTH)
GL_SPLITS = (GL_KWIDTH, GL_KWIDTH, GL_WIDTH, GL_GATE_LORA, GL_WIDTH)
RW_COLS = sum(RW_SPLITS)
HG_COLS = sum(HG_SPLITS)
GL_COLS = sum(GL_SPLITS)
N_IN = RW_COLS + HG_COLS + GL_COLS

kernel_name = "hybrid_rwkv7_hgrn2_gla_macaron"

F32 = jnp.float32


def split_cols(z, sizes):
    return jnp.split(z, np.cumsum(sizes)[:-1].tolist(), axis=-1)


def to_heads(z, heads):
    return z.reshape(z.shape[:-1] + (heads, z.shape[-1] // heads))


def rms_norm(x, gain):
    x32 = x.astype(F32)
    y = x32 * lax.rsqrt(jnp.mean(x32 * x32, axis=-1, keepdims=True) + NORM_EPS)
    return (y * gain.astype(F32)).astype(x.dtype)


def head_rms_norm(o, gain):
    o32 = o.astype(F32)
    o32 = o32 * lax.rsqrt(jnp.mean(o32 * o32, axis=-1, keepdims=True) + NORM_EPS)
    return o32.reshape(o.shape[:-2] + (-1,)) * gain


def swiglu(h, w_gate, w_up, w_down):
    return (jax.nn.silu(h @ w_gate) * (h @ w_up)) @ w_down


def token_shift(z, mu):
    prev = jnp.pad(z[:, :-1], ((0, 0), (1, 0), (0, 0)))
    return z + (prev - z) * mu


def causal_depthwise_conv(z, w):
    return lax.conv_general_dilated(
        z, w.astype(z.dtype)[:, None, :], window_strides=(1,), padding=[(GL_CONV_WIDTH - 1, 0)],
        dimension_numbers=("NWC", "WIO", "NWC"), feature_group_count=z.shape[-1])


def chunk_gla(q, k, v, log_a):
    dtype = v.dtype
    bsz, seq, heads, dk = q.shape
    dv = v.shape[-1]
    n = seq // CHUNK

    def blocks(z):
        return jnp.moveaxis(z.astype(F32).reshape(bsz, n, CHUNK, heads, z.shape[-1]), 1, 0)

    causal = jnp.tril(jnp.ones((CHUNK, CHUNK), bool))[None, :, :, None, None]

    def step(s, inp):
        qc, kc, vc, lc = inp
        g = jnp.cumsum(lc, axis=1)
        diff = jnp.where(causal, g[:, :, None] - g[:, None], 0.0)
        decay = jnp.where(causal, jnp.exp(diff), 0.0)
        attn = jnp.einsum('bshc,bjhc,bsjhc->bhsj', qc, kc, decay)
        o = (jnp.einsum('bhsj,bjhv->bshv', attn, vc)
             + jnp.einsum('bshc,bhcv->bshv', qc * jnp.exp(g), s))
        g_last = g[:, -1]
        s = (jnp.exp(g_last)[..., None] * s
             + jnp.einsum('bjhc,bjhv->bhcv', kc * jnp.exp(g_last[:, None] - g), vc))
        return s, o

    s0 = jnp.zeros((bsz, heads, dk, dv), F32)
    _, o = lax.scan(step, s0, (blocks(q), blocks(k), blocks(v), blocks(log_a)))
    return jnp.moveaxis(o, 0, 1).reshape(bsz, seq, heads, dv).astype(dtype)


def rwkv7_chunk(r, log_w, k, v, alpha, beta):
    dtype = v.dtype
    bsz, seq, heads, dk = r.shape
    dv = v.shape[-1]
    n = seq // CHUNK

    def blocks(z):
        return jnp.swapaxes(z.astype(F32).reshape(bsz, n, CHUNK, heads, z.shape[-1]), 2, 3)

    r, log_w, k, v, alpha, beta = (blocks(z) for z in (r, log_w, k, v, alpha, beta))
    g = jnp.cumsum(log_w, axis=3)
    g_last = g[:, :, :, -1:]
    inv = jnp.exp(-g)
    k_in, a_in = k * inv, alpha * inv
    beta_d = beta * jnp.exp(g - log_w)
    r_d = r * jnp.exp(g)
    strict = jnp.tril(jnp.ones((CHUNK, CHUNK), bool), -1)
    incl = jnp.tril(jnp.ones((CHUNK, CHUNK), bool))

    def pair(lhs, rhs, mask):
        return jnp.where(mask, jnp.einsum('bnhtc,bnhjc->bnhtj', lhs, rhs), 0.0)

    a_bk, a_ba = pair(beta_d, k_in, strict), pair(beta_d, a_in, strict)
    a_rk, a_ra = pair(r_d, k_in, incl), pair(r_d, a_in, incl)
    rhs = jnp.concatenate([beta_d, a_bk @ v], axis=-1)
    sol = lax.linalg.triangular_solve(a_ba, rhs, left_side=True, lower=True, unit_diagonal=True)
    w_s, u_s = sol[..., :dk], sol[..., dk:]
    q_eff = r_d - a_ra @ w_s
    o_intra = a_rk @ v - a_ra @ u_s
    dec = jnp.exp(g_last - g)
    k_end, a_end = k * dec, alpha * dec
    lowrank = jnp.einsum('bnhjc,bnhjd->bnhcd', a_end, w_s)
    upd = (jnp.einsum('bnhjc,bnhjv->bnhcv', k_end, v)
           - jnp.einsum('bnhjc,bnhjv->bnhcv', a_end, u_s))
    chunk_decay = jnp.exp(g_last[:, :, :, 0])

    def step(s, inp):
        d, lr, up, qe = inp
        o = qe @ s
        s = d[..., None] * s - lr @ s + up
        return s, o

    s0 = jnp.zeros((bsz, heads, dk, dv), F32)
    xs = tuple(jnp.moveaxis(z, 1, 0) for z in (chunk_decay, lowrank, upd, q_eff))
    _, o_inter = lax.scan(step, s0, xs)
    o = o_intra + jnp.moveaxis(o_inter, 0, 1)
    return jnp.swapaxes(o, 2, 3).reshape(bsz, seq, heads, dv).astype(dtype)


def rwkv7_mixer(z, vres_z, v_first, mu, w0, w_up, a0, a_up, g_up, k_k, k_a, r_k, ln_w, ln_b,
                vres_mu, v0, vres_up):
    z = token_shift(z, mu)
    r, k, v, w_dn, a_dn, g_dn = split_cols(z, RW_SPLITS)
    log_w = -jnp.exp(-jax.nn.softplus(-(w0 + jnp.tanh(w_dn) @ w_up).astype(F32)) - 0.5)
    a = jax.nn.sigmoid(a0 + a_dn @ a_up)
    g = jax.nn.sigmoid(g_dn) @ g_up
    if vres_z is None:
        v_first = v
    else:
        vres_z = token_shift(vres_z, vres_mu)
        v = v + (v_first - v) * jax.nn.sigmoid(v0 + vres_z @ vres_up)
    kk = to_heads(k * k_k, RW_HEADS).astype(F32)
    kk = kk / jnp.maximum(jnp.sqrt(jnp.sum(kk * kk, axis=-1, keepdims=True)), L2_EPS)
    k = k * (1 + (a - 1) * k_a)
    rh, kh, vh, ah = (to_heads(t, RW_HEADS) for t in (r, k, v, a))
    y = rwkv7_chunk(rh, to_heads(log_w, RW_HEADS), kh, vh, kk * ah, kk).astype(F32)
    mean = jnp.mean(y, axis=-1, keepdims=True)
    var = jnp.mean(jnp.square(y - mean), axis=-1, keepdims=True)
    y = ((y - mean) * lax.rsqrt(var + RW_GN_EPS)).reshape(z.shape[:-1] + (RW_WIDTH,))
    y = y * ln_w + ln_b
    bonus = jnp.sum(rh * kh * r_k, axis=-1, keepdims=True) * vh
    out = (y + bonus.reshape(y.shape)) * g
    return out, v_first


def hgrn2_mixer(z, lb, norm_gain):
    q, f, i, g = split_cols(z, HG_SPLITS)
    f = f.astype(F32)
    lb = lb.astype(F32)
    forget = lb + (1 - lb) * jax.nn.sigmoid(f)
    log_f = jnp.log(jnp.maximum(forget, HG_GATE_FLOOR))
    k = (1 - lb) * jax.nn.sigmoid(-f)
    o = chunk_gla(to_heads(jax.nn.silu(q), HG_HEADS), to_heads(k, HG_HEADS),
                  to_heads(i, HG_HEADS), to_heads(log_f, HG_HEADS))
    return head_rms_norm(o, norm_gain) * jax.nn.silu(g)


def gla_mixer(z, conv_w, gate_up, gate_b, norm_gain):
    q, k, v, gate_dn, og = split_cols(z, GL_SPLITS)
    qkv = jax.nn.silu(causal_depthwise_conv(jnp.concatenate([q, k, v], axis=-1), conv_w))
    q, k, v = split_cols(qkv, (GL_KWIDTH, GL_KWIDTH, GL_WIDTH))
    log_a = jax.nn.log_sigmoid((gate_dn @ gate_up + gate_b).astype(F32)) / GL_GATE_NORMALIZER
    o = chunk_gla(to_heads(q * GL_KEY_DIM ** -0.5, GL_HEADS), to_heads(k, GL_HEADS),
                  to_heads(v, GL_HEADS), to_heads(log_a, GL_HEADS))
    return head_rms_norm(o, norm_gain) * jax.nn.silu(og)


def setup_inputs(seed: int = 0) -> dict:
    key = jax.random.key(seed)
    ks = iter(jax.random.split(key, 64))
    L, LV = DEPTH, DEPTH - 1

    def nrm(shape, scale):
        return scale * jax.random.normal(next(ks), shape, F32)

    def gain(shape):
        return 1.0 + nrm(shape, 0.02)

    def uni(shape, lo, hi):
        return jax.random.uniform(next(ks), shape, F32, lo, hi)

    return {
        "x": nrm((BATCH, SEQ, D_MODEL), 1.0),
        "ffn1_norm": gain((L, D_MODEL)),
        "ffn1_w_gate": nrm((L, D_MODEL, D_FF), D_MODEL ** -0.5),
        "ffn1_w_up": nrm((L, D_MODEL, D_FF), D_MODEL ** -0.5),
        "ffn1_w_down": nrm((L, D_FF, D_MODEL), D_FF ** -0.5),
        "mix_norm": gain((L, D_MODEL)),
        "w_in": nrm((L, D_MODEL, N_IN), D_MODEL ** -0.5),
        "w_out": nrm((L, D_MIX, D_MODEL), D_MIX ** -0.5),
        "rw_mu": uni((L, RW_COLS), 0.0, 1.0),
        "rw_w0": uni((L, RW_WIDTH), -2.0, 1.0),
        "rw_w_up": nrm((L, RW_DECAY_LORA, RW_WIDTH), RW_DECAY_LORA ** -0.5),
        "rw_a0": nrm((L, RW_WIDTH), 0.5),
        "rw_a_up": nrm((L, RW_AAA_LORA, RW_WIDTH), RW_AAA_LORA ** -0.5),
        "rw_g_up": nrm((L, RW_GATE_LORA, RW_WIDTH), RW_GATE_LORA ** -0.5),
        "rw_k_k": 0.85 + nrm((L, RW_WIDTH), 0.05),
        "rw_k_a": 1.0 + nrm((L, RW_WIDTH), 0.05),
        "rw_r_k": nrm((L, RW_HEADS, HEAD_DIM), 0.1),
        "rw_ln_w": gain((L, RW_WIDTH)),
        "rw_ln_b": nrm((L, RW_WIDTH), 0.01),
        "rw_vres_down": nrm((LV, D_MODEL, RW_MV_LORA), D_MODEL ** -0.5),
        "rw_vres_mu": uni((LV, RW_MV_LORA), 0.0, 1.0),
        "rw_v0": nrm((LV, RW_WIDTH), 0.5),
        "rw_vres_up": nrm((LV, RW_MV_LORA, RW_WIDTH), RW_MV_LORA ** -0.5),
        "hg_lb_logits": nrm((L, HG_FDIM), 0.5),
        "hg_norm": gain((L, HG_WIDTH)),
        "gl_conv": nrm((L, GL_CONV_WIDTH, GL_CONV_CH), GL_CONV_WIDTH ** -0.5),
        "gl_gate_up": nrm((L, GL_GATE_LORA, GL_KWIDTH), GL_GATE_LORA ** -0.5),
        "gl_gate_b": nrm((L, GL_KWIDTH), 0.1),
        "gl_norm": gain((L, GL_WIDTH)),
        "ffn2_norm": gain((L, D_MODEL)),
        "ffn2_w_gate": nrm((L, D_MODEL, D_FF), D_MODEL ** -0.5),
        "ffn2_w_up": nrm((L, D_MODEL, D_FF), D_MODEL ** -0.5),
        "ffn2_w_down": nrm((L, D_FF, D_MODEL), D_FF ** -0.5),
        "final_norm": gain((D_MODEL,)),
    }


def reference(x, ffn1_norm, ffn1_w_gate, ffn1_w_up, ffn1_w_down, mix_norm, w_in, w_out,
              rw_mu, rw_w0, rw_w_up, rw_a0, rw_a_up, rw_g_up, rw_k_k, rw_k_a, rw_r_k, rw_ln_w, rw_ln_b,
              rw_vres_down, rw_vres_mu, rw_v0, rw_vres_up, hg_lb_logits, hg_norm,
              gl_conv, gl_gate_up, gl_gate_b, gl_norm,
              ffn2_norm, ffn2_w_gate, ffn2_w_up, ffn2_w_down, final_norm):
    p = jax.nn.softmax(hg_lb_logits.astype(F32), axis=0)
    lower_bounds = jnp.cumsum(p, axis=0) - p[0]
    v_first = None
    for l in range(DEPTH):
        h = rms_norm(x, ffn1_norm[l])
        x = x + FFN_RESIDUAL_WEIGHT * swiglu(h, ffn1_w_gate[l], ffn1_w_up[l], ffn1_w_down[l])
        h = rms_norm(x, mix_norm[l])
        if l == 0:
            proj = h @ w_in[l]
            vres_z, vres_mu, v0, vres_up = None, None, None, None
        else:
            proj = h @ jnp.concatenate([w_in[l], rw_vres_down[l - 1]], axis=1)
            vres_z = proj[..., N_IN:]
            vres_mu, v0, vres_up = rw_vres_mu[l - 1], rw_v0[l - 1], rw_vres_up[l - 1]
        rw_z = proj[..., :RW_COLS]
        hg_z = proj[..., RW_COLS:RW_COLS + HG_COLS]
        gl_z = proj[..., RW_COLS + HG_COLS:N_IN]
        rw_o, v_first = rwkv7_mixer(rw_z, vres_z, v_first, rw_mu[l], rw_w0[l], rw_w_up[l], rw_a0[l],
                                    rw_a_up[l], rw_g_up[l], rw_k_k[l], rw_k_a[l], rw_r_k[l],
                                    rw_ln_w[l], rw_ln_b[l], vres_mu, v0, vres_up)
        hg_o = hgrn2_mixer(hg_z, lower_bounds[l], hg_norm[l])
        gl_o = gla_mixer(gl_z, gl_conv[l], gl_gate_up[l], gl_gate_b[l], gl_norm[l])
        mixed = jnp.concatenate([rw_o, hg_o, gl_o], axis=-1)
        x = x + (mixed @ w_out[l]).astype(x.dtype)
        h = rms_norm(x, ffn2_norm[l])
        x = x + FFN_RESIDUAL_WEIGHT * swiglu(h, ffn2_w_gate[l], ffn2_w_up[l], ffn2_w_down[l])
    return rms_norm(x, final_norm)
```

```cpp
#include <hip/hip_runtime.h>
#include <hip/hip_cooperative_groups.h>
#include <cstdio>
#include <cstdint>
namespace cg = cooperative_groups;

constexpr int T = 16384, D = 1024, FF = 2816, NLAYER = 4;
constexpr int RWW = 384;
constexpr int PRW = 1536, PHG = 1536, PGL = 1280;
constexpr int NIN = 4112, NINP = 4352;
constexpr int SEG = 128, NSEG = T / SEG;
constexpr int TS = 16;

constexpr size_t MiB = 1024 * 1024;
constexpr size_t WS_X     = 0;
constexpr size_t WS_WUP1  = WS_X + (size_t)T * D * 4;
constexpr size_t WS_WDN1  = WS_WUP1 + (size_t)2 * FF * D * 2;
constexpr size_t WS_WUP2  = WS_WDN1 + (size_t)FF * D * 2;
constexpr size_t WS_WDN2  = WS_WUP2 + (size_t)2 * FF * D * 2;
constexpr size_t WS_WIN   = WS_WDN2 + (size_t)FF * D * 2;
constexpr size_t WS_WOUT  = WS_WIN + (size_t)NINP * D * 2;
constexpr size_t WS_VF    = WS_WOUT + (size_t)D * D * 2;
constexpr size_t WS_H     = WS_VF + (size_t)T * RWW * 2;
constexpr size_t WS_ACT   = WS_H + (size_t)T * D * 2;
constexpr size_t WS_PHG   = WS_ACT;
constexpr size_t WS_PGL   = WS_PHG + (size_t)T * PHG * 2;
constexpr size_t WS_PRW   = WS_ACT + (size_t)T * FF * 2;
constexpr size_t WS_RWL   = WS_PRW;
constexpr size_t WS_RWP   = WS_RWL + (size_t)NSEG * 6 * 4096 * 4;
constexpr size_t WS_HGL   = WS_RWP + (size_t)NSEG * 6 * 4096 * 4;
constexpr size_t WS_RWOPS = WS_PRW + (size_t)T * PRW * 2;
constexpr size_t WS_R     = WS_RWOPS;
constexpr size_t WS_K     = WS_R + (size_t)T * RWW * 2;
constexpr size_t WS_V     = WS_K + (size_t)T * RWW * 2;
constexpr size_t WS_BE    = WS_V + (size_t)T * RWW * 2;
constexpr size_t WS_AL    = WS_BE + (size_t)T * RWW * 2;
constexpr size_t WS_G     = WS_AL + (size_t)T * RWW * 2;
constexpr size_t WS_W     = WS_G + (size_t)T * RWW * 2;
constexpr size_t WS_RK    = WS_W + (size_t)T * RWW * 4;
constexpr size_t WS_GLL   = WS_RK + (size_t)T * 8 * 4;
constexpr size_t WS_HGD   = WS_GLL + (size_t)NSEG * 4 * 4608 * 4;
constexpr size_t WS_GLD   = WS_HGD + (size_t)NSEG * 4 * 128 * 4;
constexpr size_t WS_LW    = WS_GLD + (size_t)NSEG * 4 * 48 * 4;
constexpr size_t WS_LA    = WS_LW + 384 * 64 * 2;
constexpr size_t WS_LG    = WS_LA + 384 * 64 * 2;
constexpr size_t WS_LV    = WS_LG + 384 * 128 * 2;
constexpr size_t WS_BAR   = WS_LV + 384 * 32 * 2;
constexpr size_t WS_END   = WS_BAR + 16384;
static_assert(WS_HGL + (size_t)NSEG * 4 * 8192 * 4 <= WS_RWOPS, "segment states must fit in the projRW region");
static_assert(WS_PGL + (size_t)T * PGL * 2 <= WS_PRW, "projHG + projGL must fit in the act region");
static_assert(WS_END <= (size_t)430438272, "workspace");

#define LAS __attribute__((address_space(3)))
constexpr int LDS_BYTES = 147456;

namespace pg8 {
#define PG8_LAS __attribute__((address_space(3)))
typedef unsigned short bf16_t;
typedef short bf16x8 __attribute__((ext_vector_type(8)));
typedef float f32x4 __attribute__((ext_vector_type(4)));
typedef unsigned u32x4 __attribute__((ext_vector_type(4)));
constexpr int BM = 256, BK = 64, HALF = 128, HTB = HALF * BK * 2  , STAGE_BYTES = 8 * HTB, NXCD = 8, WGM = 8;

__host__ __device__ __forceinline__ int lds_byte(int r, int c) { const int st = (r >> 4) * 2 + (c >> 5), rr = r & 15, cc = c & 31, ob = rr * 64 + cc * 2; return st * 1024 + (ob ^ (((ob >> 9) & 1) << 5)); }
__host__ __device__ __forceinline__ void stage_rc(int b, int& R, int& C) { const int st = b / 1024, sb = b % 1024, swz = sb ^ (((sb >> 9) & 1) << 5); R = (st >> 1) * 16 + swz / 64; C = (st & 1) * 32 + (swz % 64) / 2; }
__host__ __device__ __forceinline__ int perm32(int rho) { const int n = rho >> 4, i = rho & 15; return 8 * (i >> 2) + 4 * n + (i & 3); }

struct Unit { int pm, pn; };
struct Gemm { const bf16_t* A; const bf16_t* Bt; int M, N, K; };

struct StaticOrder {
    int nM, nN, nwg, G, c;
    __host__ __device__ void init(int M, int N, int G_, int c_) { nM = M / BM; nN = N / BM; nwg = nM * nN; G = G_; c = c_; }
    __host__ __device__ bool next(int i, Unit& u) const {
        const long L = (long)i * G + c; if (L >= nwg) return false;
        int wgid = (int)L; { const int q = nwg / NXCD, r = nwg % NXCD, xcd = wgid % NXCD, off = wgid / NXCD; wgid = (xcd < r ? xcd * (q + 1) : r * (q + 1) + (xcd - r) * q) + off; }
        const int nig = WGM * nN, gid = wgid / nig, fm = gid * WGM, gsz = (nM - fm) < WGM ? (nM - fm) : WGM;
        u.pm = fm + ((wgid % nig) % gsz); u.pn = (wgid % nig) / gsz; return true;
    }
    __device__ __forceinline__ void a_ready(const Unit&) const {}
    __device__ __forceinline__ void done(const Unit&) const {}
};
__device__ __forceinline__ unsigned cvt_pk_bf16(float lo, float hi) { unsigned r; asm volatile("v_cvt_pk_bf16_f32 %0, %1, %2" : "=v"(r) : "v"(lo), "v"(hi)); return r; }
template <class Epi, class Sched>
__device__ __forceinline__ void gemm_phase(PG8_LAS unsigned char* lds, const Gemm g, const Sched& S, const Epi& E) {
    int tid_o = threadIdx.x; asm volatile("" : "+v"(tid_o)); const int tid = tid_o, wid = __builtin_amdgcn_readfirstlane(tid >> 6), lane = tid & 63, wr = wid >> 2, wc = wid & 3, fr = lane & 15, fq = lane >> 4;
    const int K = g.K, nt = K / BK;
    unsigned voffA[2], voffB[2];
#pragma unroll
    for (int i = 0; i < 2; ++i) { int R, C; stage_rc(tid * 16 + i * 8192, R, C); const int Rb = Epi::PERM ? ((R & ~31) + perm32(R & 31)) : R;
        voffA[i] = (unsigned)(R * K + C) * 2u; voffB[i] = (unsigned)(Rb * K + C) * 2u; }
    const size_t kstep = (size_t)(BK * 2);
    const size_t hstep = (size_t)HALF * K * 2;
    const size_t tstep = 2 * hstep;
    const unsigned ldsw = (unsigned)wid * 1024u;
    const int aoff = lds_byte(wr * 64 + fr, fq * 8), boff = lds_byte(wc * 32 + fr, fq * 8);
#define PG8_SA(b, h) (((b) * 2 + (h)) * HTB)
#define PG8_SB(b, h) ((4 + (b) * 2 + (h)) * HTB)
#define PG8_STAGE(bufoff, gbase, voff) do { _Pragma("unroll") for (int _i = 0; _i < 2; ++_i) \
        __builtin_amdgcn_global_load_lds((const unsigned*)((const char*)(gbase) + (voff)[_i]), (PG8_LAS unsigned*)(lds + (bufoff) + ldsw + _i * 8192), 16, 0, 0); } while (0)
#define PG8_LDA(dst, b, h) do { _Pragma("unroll") for (int m = 0; m < 4; ++m) _Pragma("unroll") for (int k = 0; k < 2; ++k) dst[m][k] = *(const PG8_LAS bf16x8*)(lds + PG8_SA(b, h) + aoff + m * 2048 + k * 1024); } while (0)
#define PG8_LDB(dst, b, h) do { _Pragma("unroll") for (int n = 0; n < 2; ++n) _Pragma("unroll") for (int k = 0; k < 2; ++k) dst[n][k] = *(const PG8_LAS bf16x8*)(lds + PG8_SB(b, h) + boff + n * 2048 + k * 1024); } while (0)
#define PG8_MMA(ai, bj, At, Bt) do { __builtin_amdgcn_s_setprio(1); _Pragma("unroll") for (int m = 0; m < 4; ++m) _Pragma("unroll") for (int n = 0; n < 2; ++n) _Pragma("unroll") for (int k = 0; k < 2; ++k) \
        acc[ai][bj][m][n] = __builtin_amdgcn_mfma_f32_16x16x32_bf16(Bt[n][k], At[m][k], acc[ai][bj][m][n], 0, 0, 0); __builtin_amdgcn_s_setprio(0); } while (0)
#define PG8_WAIT_V(n) asm volatile("s_waitcnt vmcnt(" #n ")" ::: "memory")
#define PG8_WAIT_L(n) asm volatile("s_waitcnt lgkmcnt(" #n ")" ::: "memory")
#define PG8_BAR __builtin_amdgcn_s_barrier()
#define PG8_SCHED __builtin_amdgcn_sched_barrier(0)
    Unit cur, nxt; int ui = 0;
    if (!S.next(0, cur)) return;
    f32x4 acc[2][2][4][2];
#pragma unroll
    for (int a = 0; a < 2; ++a)
#pragma unroll
        for (int b = 0; b < 2; ++b)
#pragma unroll
            for (int m = 0; m < 4; ++m)
#pragma unroll
                for (int n = 0; n < 2; ++n) acc[a][b][m][n] = (f32x4){0.f, 0.f, 0.f, 0.f};
    bf16x8 At[4][2], B0[2][2], B1[2][2];
    const char* cA = (const char*)g.A + (size_t)cur.pm * tstep; const char* cB = (const char*)g.Bt + (size_t)cur.pn * tstep;
    S.a_ready(cur);
    PG8_STAGE(PG8_SB(0, 0), cB, voffB); PG8_STAGE(PG8_SA(0, 0), cA, voffA); PG8_STAGE(PG8_SB(0, 1), cB + hstep, voffB); PG8_STAGE(PG8_SA(0, 1), cA + hstep, voffA);
    if (wr == 1) PG8_BAR;
    PG8_WAIT_V(4); PG8_BAR;
    PG8_STAGE(PG8_SB(1, 0), cB + kstep, voffB); PG8_STAGE(PG8_SA(1, 0), cA + kstep, voffA); PG8_STAGE(PG8_SB(1, 1), cB + hstep + kstep, voffB);
    PG8_WAIT_V(6); PG8_BAR;
    for (;;) {
        const bool has_next = S.next(ui + 1, nxt);
        const char* nA = has_next ? (const char*)g.A + (size_t)nxt.pm * tstep : cA; const char* nB = has_next ? (const char*)g.Bt + (size_t)nxt.pn * tstep : cB;
        for (int t = 0; t < nt; t += 2) {
            const bool last = (t == nt - 2);
            const char* a1 = cA + (size_t)(t + 1) * kstep;
            const char* a2 = last ? nA : cA + (size_t)(t + 2) * kstep; const char* b2 = last ? nB : cB + (size_t)(t + 2) * kstep;
            const char* a3 = a2 + kstep; const char* b3 = b2 + kstep;
            if (last && has_next) S.a_ready(nxt);
            PG8_LDB(B0, 0, 0); PG8_SCHED; PG8_LDA(At, 0, 0); PG8_STAGE(PG8_SA(1, 1), a1 + hstep, voffA);
            PG8_WAIT_L(8); PG8_BAR; PG8_WAIT_L(0); PG8_MMA(0, 0, At, B0); PG8_BAR; PG8_SCHED;
            PG8_LDB(B1, 0, 1); PG8_STAGE(PG8_SB(0, 0), b2, voffB);
            PG8_BAR; PG8_WAIT_L(0); PG8_MMA(0, 1, At, B1); PG8_BAR;
            PG8_LDA(At, 0, 1); PG8_STAGE(PG8_SA(0, 0), a2, voffA);
            PG8_BAR; PG8_WAIT_L(0); PG8_MMA(1, 0, At, B0); PG8_BAR; PG8_SCHED;
            PG8_STAGE(PG8_SB(0, 1), b2 + hstep, voffB);
            PG8_WAIT_V(6); PG8_BAR; PG8_MMA(1, 1, At, B1); PG8_BAR;
            PG8_LDB(B0, 1, 0); PG8_SCHED; PG8_LDA(At, 1, 0); PG8_STAGE(PG8_SA(0, 1), a2 + hstep, voffA);
            PG8_WAIT_L(8); PG8_BAR; PG8_WAIT_L(0); PG8_MMA(0, 0, At, B0); PG8_BAR; PG8_SCHED;
            PG8_LDB(B1, 1, 1); PG8_STAGE(PG8_SB(1, 0), b3, voffB);
            PG8_BAR; PG8_WAIT_L(0); PG8_MMA(0, 1, At, B1); PG8_BAR;
            PG8_LDA(At, 1, 1); PG8_STAGE(PG8_SA(1, 0), a3, voffA);
            PG8_BAR; PG8_WAIT_L(0); PG8_MMA(1, 0, At, B0); PG8_BAR; PG8_SCHED;
            PG8_STAGE(PG8_SB(1, 1), b3 + hstep, voffB);
            PG8_WAIT_V(6); PG8_BAR; PG8_MMA(1, 1, At, B1); PG8_BAR;
        }
        if constexpr (!Epi::AFTER_DRAIN) { E(acc, cur, wr, wc, fr, fq); S.done(cur); }
        if (!has_next) break;
#pragma unroll
        for (int a = 0; a < 2; ++a)
#pragma unroll
            for (int b = 0; b < 2; ++b)
#pragma unroll
                for (int m = 0; m < 4; ++m)
#pragma unroll
                    for (int n = 0; n < 2; ++n) acc[a][b][m][n] = (f32x4){0.f, 0.f, 0.f, 0.f};
        cur = nxt; cA = nA; cB = nB; ++ui;
    }
    PG8_WAIT_V(0);
    if (wr == 0) PG8_BAR;
    PG8_BAR;
    if constexpr (Epi::AFTER_DRAIN) { E.fused(acc, cur, wr, wc, fr, fq, lds, wid, lane); S.done(cur); }
#undef PG8_SA
#undef PG8_SB
#undef PG8_STAGE
#undef PG8_LDA
#undef PG8_LDB
#undef PG8_MMA
#undef PG8_WAIT_V
#undef PG8_WAIT_L
#undef PG8_BAR
#undef PG8_SCHED
}
}


typedef pg8::bf16_t bf16_t;
typedef pg8::f32x4 f32x4;
typedef pg8::u32x4 u32x4;
typedef unsigned u32x2 __attribute__((ext_vector_type(2)));
typedef float f32x2 __attribute__((ext_vector_type(2)));

struct KArgs { const float* in[34]; float* out; unsigned char* ws; };
constexpr int TBL_OFF = 145408;
struct Params {
    LAS const unsigned* tbl;
    __device__ __forceinline__ unsigned long long ld(int i) const {
        const unsigned lo = __builtin_amdgcn_readfirstlane(tbl[2 * i]), hi = __builtin_amdgcn_readfirstlane(tbl[2 * i + 1]);
        return ((unsigned long long)hi << 32) | lo;
    }
    __device__ __forceinline__ const float* in(int i) const { return (const float*)(const __attribute__((address_space(1))) float*)ld(i); }
    __device__ __forceinline__ float* out() const { return (float*)(__attribute__((address_space(1))) float*)ld(34); }
    __device__ __forceinline__ unsigned char* ws() const { return (unsigned char*)(__attribute__((address_space(1))) unsigned char*)ld(35); }
};

__device__ __forceinline__ float bf2f(bf16_t b) { return __uint_as_float(((unsigned)b) << 16); }
__device__ __forceinline__ bf16_t f2bf(float f) { unsigned u = __float_as_uint(f); u += 0x7FFFu + ((u >> 16) & 1u); return (bf16_t)(u >> 16); }
__device__ __forceinline__ unsigned pk2(float lo, float hi) { return pg8::cvt_pk_bf16(lo, hi); }
__device__ __forceinline__ float sigm(float x) { return __builtin_amdgcn_rcpf(1.0f + __expf(-x)); }
__device__ __forceinline__ float silu(float x) { return x * __builtin_amdgcn_rcpf(1.0f + __expf(-x)); }
template <int CTRL> __device__ __forceinline__ float dpp_mov(float v) { return __int_as_float(__builtin_amdgcn_update_dpp(0, __float_as_int(v), CTRL, 0xF, 0xF, true)); }
__device__ __forceinline__ float wave_sum(float v) {
    v += dpp_mov<0xB1>(v); v += dpp_mov<0x4E>(v); v += dpp_mov<0x141>(v); v += dpp_mov<0x140>(v);
    v += __int_as_float(__builtin_amdgcn_update_dpp(0, __float_as_int(v), 0x142, 0xa, 0xf, false));
    v += __int_as_float(__builtin_amdgcn_update_dpp(0, __float_as_int(v), 0x143, 0xc, 0xf, false));
    return __int_as_float(__builtin_amdgcn_readlane(__float_as_int(v), 63));
}
#define LDS_WAIT() asm volatile("s_waitcnt lgkmcnt(0)" ::: "memory")
__device__ __forceinline__ void lds_barrier() { asm volatile("s_waitcnt lgkmcnt(0)" ::: "memory"); __builtin_amdgcn_s_barrier(); asm volatile("" ::: "memory"); }

struct EpiSwiglu {
    static constexpr bool PERM = true, AFTER_DRAIN = false;
    bf16_t* O;
    __device__ __forceinline__ void operator()(const f32x4 (&acc)[2][2][4][2], const pg8::Unit& u, int wr, int wc, int fr, int fq) const {
        const int row0 = u.pm * 256 + wr * 64 + fr, col0 = u.pn * 128 + wc * 32 + 8 * fq;
#pragma unroll
        for (int ai = 0; ai < 2; ++ai)
#pragma unroll
            for (int m = 0; m < 4; ++m) {
                bf16_t* p = O + (size_t)(row0 + ai * 128 + m * 16) * FF + col0;
                const f32x4 g0 = acc[ai][0][m][0], g1 = acc[ai][0][m][1], u0 = acc[ai][1][m][0], u1 = acc[ai][1][m][1];
                u32x4 w;
                w.x = pk2(silu(g0[0]) * u0[0], silu(g0[1]) * u0[1]); w.y = pk2(silu(g0[2]) * u0[2], silu(g0[3]) * u0[3]);
                w.z = pk2(silu(g1[0]) * u1[0], silu(g1[1]) * u1[1]); w.w = pk2(silu(g1[2]) * u1[2], silu(g1[3]) * u1[3]);
                *(u32x4*)p = w;
            }
    }
};
struct EpiResid {
    static constexpr bool PERM = false, AFTER_DRAIN = false;
    float* X; const float* Xs; float scale;
    __device__ __forceinline__ void operator()(const f32x4 (&acc)[2][2][4][2], const pg8::Unit& u, int wr, int wc, int fr, int fq) const {
        const int row0 = u.pm * 256 + wr * 64 + fr, col0 = u.pn * 256 + wc * 32 + 4 * fq;
#pragma unroll
        for (int ai = 0; ai < 2; ++ai)
#pragma unroll
            for (int m = 0; m < 4; ++m) {
                const size_t ro = (size_t)(row0 + ai * 128 + m * 16) * D + col0;
#pragma unroll
                for (int bj = 0; bj < 2; ++bj)
#pragma unroll
                    for (int n = 0; n < 2; ++n) { const size_t o = ro + bj * 128 + n * 16; *(f32x4*)(X + o) = *(const f32x4*)(Xs + o) + acc[ai][bj][m][n] * scale; }
            }
    }
};
struct EpiProj {
    static constexpr bool PERM = true, AFTER_DRAIN = false;
    bf16_t *PR, *PH, *PG;
    __device__ __forceinline__ void operator()(const f32x4 (&acc)[2][2][4][2], const pg8::Unit& u, int wr, int wc, int fr, int fq) const {
        bf16_t* base; int pitch, colt;
        if (u.pn < 6) { base = PR; pitch = PRW; colt = 256 * u.pn; }
        else if (u.pn < 12) { base = PH; pitch = PHG; colt = 256 * (u.pn - 6); }
        else { base = PG; pitch = PGL; colt = 256 * (u.pn - 12); }
        const int row0 = u.pm * 256 + wr * 64 + fr, col0 = colt + wc * 32 + 8 * fq;
#pragma unroll
        for (int ai = 0; ai < 2; ++ai)
#pragma unroll
            for (int m = 0; m < 4; ++m) {
                bf16_t* rowp = base + (size_t)(row0 + ai * 128 + m * 16) * pitch + col0;
#pragma unroll
                for (int bj = 0; bj < 2; ++bj) {
                    const f32x4 v0 = acc[ai][bj][m][0], v1 = acc[ai][bj][m][1];
                    u32x4 w; w.x = pk2(v0[0], v0[1]); w.y = pk2(v0[2], v0[3]); w.z = pk2(v1[0], v1[1]); w.w = pk2(v1[2], v1[3]);
                    *(u32x4*)(rowp + bj * 128) = w;
                }
            }
    }
};

__device__ __forceinline__ void tr_item(const float* W, int K, int N, bf16_t* WT, int rowbase, int k0, int n0, LAS float* scr, int lane) {
    const int n = n0 + (lane & 31);
    float tv[32];
#pragma unroll
    for (int i = 0; i < 32; ++i) { const int kk = 2 * i + (lane >> 5); tv[i] = 0.f; if (n < N) tv[i] = W[(size_t)(k0 + kk) * N + n]; }
#pragma unroll
    for (int i = 0; i < 32; ++i) { const int kk = 2 * i + (lane >> 5); scr[kk * 33 + (lane & 31)] = tv[i]; }
    LDS_WAIT();
    const int c = lane & 7;
#pragma unroll
    for (int j = 0; j < 4; ++j) {
        const int nn = (lane >> 3) + 8 * j; const LAS float* s = scr + (8 * c) * 33 + nn;
        u32x4 o; o.x = pk2(s[0 * 33], s[1 * 33]); o.y = pk2(s[2 * 33], s[3 * 33]); o.z = pk2(s[4 * 33], s[5 * 33]); o.w = pk2(s[6 * 33], s[7 * 33]);
        *(u32x4*)(WT + (size_t)(rowbase + nn) * K + k0 + 8 * c) = o;
    }
    LDS_WAIT();
}

__device__ __forceinline__ void phase_convert(const Params& p, int l, LAS unsigned char* lds, int gw, int ngw, int wave, int lane) {
    LAS float* scr = (LAS float*)(lds + wave * 8704);
    unsigned char* ws = p.ws();
    constexpr int I_UP = 16 * 88, I_DN = 44 * 32, I_IN = 16 * 129, I_VR = 16, I_OUT = 16 * 32, I_Z = 192;
    constexpr int NIT = 4 * I_UP + 2 * I_DN + I_IN + I_VR + I_OUT + I_Z;
    for (int it = gw; it < NIT; it += ngw) {
        int r = it;
        if (r < 4 * I_UP) {
            const int which = r / I_UP; r -= which * I_UP;
            const int src = (which == 0) ? 2 : (which == 1) ? 3 : (which == 2) ? 30 : 31;
            bf16_t* dst = (bf16_t*)(ws + ((which < 2) ? WS_WUP1 : WS_WUP2));
            const int kb = r / 88, nb = r % 88, n0 = 32 * nb;
            const int rowbase = 256 * (n0 / 128) + (n0 % 128) + ((which & 1) ? 128 : 0);
            tr_item(p.in(src) + (size_t)l * D * FF, D, FF, dst, rowbase, 64 * kb, n0, scr, lane);
            continue;
        }
        r -= 4 * I_UP;
        if (r < 2 * I_DN) {
            const int which = r / I_DN; r -= which * I_DN;
            const int kb = r / 32, nb = r % 32;
            tr_item(p.in(which ? 32 : 4) + (size_t)l * FF * D, FF, D, (bf16_t*)(ws + (which ? WS_WDN2 : WS_WDN1)), 32 * nb, 64 * kb, 32 * nb, scr, lane);
            continue;
        }
        r -= 2 * I_DN;
        if (r < I_IN) {
            const int kb = r / 129, nb = r % 129, n0 = 32 * nb;
            const int rowbase = n0 < 1408 ? n0 : (n0 < 2944 ? 1536 + (n0 - 1408) : 3072 + (n0 - 2944));
            tr_item(p.in(6) + (size_t)l * D * NIN, D, NIN, (bf16_t*)(ws + WS_WIN), rowbase, 64 * kb, n0, scr, lane);
            continue;
        }
        r -= I_IN;
        if (r < I_VR) {
            const int lv = l > 0 ? l - 1 : 0;
            tr_item(p.in(19) + (size_t)lv * D * 32, D, l > 0 ? 32 : 0, (bf16_t*)(ws + WS_WIN), 1408, 64 * r, 0, scr, lane);
            continue;
        }
        r -= I_VR;
        if (r < I_OUT) {
            const int kb = r / 32, nb = r % 32;
            tr_item(p.in(7) + (size_t)l * D * D, D, D, (bf16_t*)(ws + WS_WOUT), 32 * nb, 64 * kb, 32 * nb, scr, lane);
            continue;
        }
        r -= I_OUT;
        {
            const int row = r < 96 ? 1440 + r : 4256 + (r - 96);
            u32x4* q = (u32x4*)((bf16_t*)(ws + WS_WIN) + (size_t)row * D);
            const u32x4 z = {0u, 0u, 0u, 0u};
            q[lane] = z; q[64 + lane] = z;
        }
    }
    {
        bf16_t* LW = (bf16_t*)(ws + WS_LW); bf16_t* LA = (bf16_t*)(ws + WS_LA); bf16_t* LG = (bf16_t*)(ws + WS_LG); bf16_t* LV = (bf16_t*)(ws + WS_LV);
        const float* wu = p.in(10) + (size_t)l * 64 * RWW; const float* au = p.in(12) + (size_t)l * 64 * RWW; const float* gu = p.in(13) + (size_t)l * 128 * RWW;
        const float* vu = p.in(22) + (size_t)(l > 0 ? l - 1 : 0) * 32 * RWW;
        for (int idx = gw * 64 + lane; idx < 110592; idx += ngw * 64) {
            if (idx < 24576) { const int c = idx >> 6, k = idx & 63; LW[idx] = f2bf(wu[k * RWW + c]); }
            else if (idx < 49152) { const int i = idx - 24576, c = i >> 6, k = i & 63; LA[i] = f2bf(au[k * RWW + c]); }
            else if (idx < 98304) { const int i = idx - 49152, c = i >> 7, k = i & 127; LG[i] = f2bf(gu[k * RWW + c]); }
            else { const int i = idx - 98304, c = i >> 5, k = i & 31; LV[i] = (l > 0) ? f2bf(vu[k * RWW + c]) : (bf16_t)0; }
        }
    }
}

__device__ __forceinline__ void phase_norm(const float* x, const float* gain, bf16_t* h, int gw, int ngw, int lane) {
    f32x4 gv[4];
#pragma unroll
    for (int j = 0; j < 4; ++j) gv[j] = *(const f32x4*)(gain + j * 256 + lane * 4);
    for (int row = gw; row < T; row += 2 * ngw) {
        const bool two = row + ngw < T;
        const int row1 = two ? row + ngw : row;
        const f32x4* xr0 = (const f32x4*)(x + (size_t)row * D) + lane; const f32x4* xr1 = (const f32x4*)(x + (size_t)row1 * D) + lane;
        f32x4 v[4], w[4]; float s0 = 0.f, s1 = 0.f;
#pragma unroll
        for (int j = 0; j < 4; ++j) { v[j] = xr0[64 * j]; w[j] = xr1[64 * j]; }
#pragma unroll
        for (int j = 0; j < 4; ++j) { s0 += (v[j].x * v[j].x + v[j].y * v[j].y) + (v[j].z * v[j].z + v[j].w * v[j].w); s1 += (w[j].x * w[j].x + w[j].y * w[j].y) + (w[j].z * w[j].z + w[j].w * w[j].w); }
        const float r0 = rsqrtf(wave_sum(s0) * (1.0f / D) + 1e-5f), r1 = rsqrtf(wave_sum(s1) * (1.0f / D) + 1e-5f);
        unsigned long long* o0 = (unsigned long long*)(h + (size_t)row * D) + lane; unsigned long long* o1 = (unsigned long long*)(h + (size_t)row1 * D) + lane;
#pragma unroll
        for (int j = 0; j < 4; ++j) {
            const f32x4 y = v[j] * r0 * gv[j], z = w[j] * r1 * gv[j];
            o0[64 * j] = (unsigned long long)pk2(y.x, y.y) | ((unsigned long long)pk2(y.z, y.w) << 32);
            o1[64 * j] = (unsigned long long)pk2(z.x, z.y) | ((unsigned long long)pk2(z.z, z.w) << 32);
        }
    }
}
__device__ __forceinline__ void phase_final_norm(const float* x, const float* gain, float* out, int gw, int ngw, int lane) {
    f32x4 gv[4];
#pragma unroll
    for (int j = 0; j < 4; ++j) gv[j] = *(const f32x4*)(gain + j * 256 + lane * 4);
    for (int row = gw; row < T; row += ngw) {
        const f32x4* xr = (const f32x4*)(x + (size_t)row * D) + lane;
        f32x4 v[4]; float s = 0.f;
#pragma unroll
        for (int j = 0; j < 4; ++j) { v[j] = xr[64 * j]; s += (v[j].x * v[j].x + v[j].y * v[j].y) + (v[j].z * v[j].z + v[j].w * v[j].w); }
        const float rstd = rsqrtf(wave_sum(s) * (1.0f / D) + 1e-5f);
        f32x4* o = (f32x4*)(out + (size_t)row * D) + lane;
#pragma unroll
        for (int j = 0; j < 4; ++j) o[64 * j] = v[j] * rstd * gv[j];
    }
}

__device__ __forceinline__ void phase_rwprep(const Params& p, int l, LAS unsigned char* lds, int tid, int lane, int wave) {
    constexpr int APITCH = 296, OUT_OFF = 16384;
    LAS bf16_t* Aimg = (LAS bf16_t*)lds;
    LAS float* outL = (LAS float*)(lds + OUT_OFF);
    unsigned char* ws = p.ws();
    const bf16_t* PR = (const bf16_t*)(ws + WS_PRW);
    bf16_t* Rr = (bf16_t*)(ws + WS_R); bf16_t* Kk = (bf16_t*)(ws + WS_K); bf16_t* Vv = (bf16_t*)(ws + WS_V);
    bf16_t* Be = (bf16_t*)(ws + WS_BE); bf16_t* Al = (bf16_t*)(ws + WS_AL); bf16_t* Gg = (bf16_t*)(ws + WS_G);
    bf16_t* VF = (bf16_t*)(ws + WS_VF);
    float* Ww = (float*)(ws + WS_W); float* RK = (float*)(ws + WS_RK);
    const bf16_t* LW = (const bf16_t*)(ws + WS_LW); const bf16_t* LA = (const bf16_t*)(ws + WS_LA);
    const bf16_t* LG = (const bf16_t*)(ws + WS_LG); const bf16_t* LV = (const bf16_t*)(ws + WS_LV);
    const float* mu = p.in(8) + l * 1408;
    const int lv = l > 0 ? l - 1 : 0;
    const float* vmu = p.in(20) + lv * 32;
    for (int tile = blockIdx.x; tile < T / 16; tile += gridDim.x) {
        const int t0 = tile * 16;
        lds_barrier();
        {
            bf16_t cu_[9], pv_[9]; float mu_[9];
#pragma unroll
            for (int e = 0; e < 9; ++e) {
                const int idx = tid + 512 * e, t = idx / 288, j = idx % 288, tok = t0 + t;
                const int col = j < 256 ? 1152 + j : 1408 + (j - 256);
                const bf16_t* q = PR + (size_t)tok * PRW + col;
                cu_[e] = q[0];
                pv_[e] = tok > 0 ? q[-PRW] : (bf16_t)0;
                mu_[e] = j < 256 ? mu[col] : vmu[j - 256];
            }
#pragma unroll
            for (int e = 0; e < 9; ++e) {
                const int idx = tid + 512 * e, t = idx / 288, j = idx % 288;
                const float cur = bf2f(cu_[e]), prev = bf2f(pv_[e]);
                const float z = cur + (prev - cur) * mu_[e];
                float val = j < 64 ? tanhf(z) : (j < 128 ? z : (j < 256 ? sigm(z) : (l > 0 ? z : 0.f)));
                Aimg[t * APITCH + j] = f2bf(val);
            }
        }
        lds_barrier();
        {
            const int row = lane & 15, q = lane >> 4;
            pg8::bf16x8 af[9];
#pragma unroll
            for (int kc = 0; kc < 9; ++kc) af[kc] = *(const LAS pg8::bf16x8*)(Aimg + row * APITCH + 32 * kc + 8 * q);
#pragma unroll
            for (int ci = 0; ci < 3; ++ci) {
                const int ct = wave + 8 * ci, col = 16 * ct + row;
                f32x4 aw = {0.f, 0.f, 0.f, 0.f}, aa = aw, ag = aw, av = aw;
#pragma unroll
                for (int kc = 0; kc < 2; ++kc) {
                    aw = __builtin_amdgcn_mfma_f32_16x16x32_bf16(af[kc], *(const pg8::bf16x8*)(LW + (size_t)col * 64 + 32 * kc + 8 * q), aw, 0, 0, 0);
                    aa = __builtin_amdgcn_mfma_f32_16x16x32_bf16(af[2 + kc], *(const pg8::bf16x8*)(LA + (size_t)col * 64 + 32 * kc + 8 * q), aa, 0, 0, 0);
                }
#pragma unroll
                for (int kc = 0; kc < 4; ++kc)
                    ag = __builtin_amdgcn_mfma_f32_16x16x32_bf16(af[4 + kc], *(const pg8::bf16x8*)(LG + (size_t)col * 128 + 32 * kc + 8 * q), ag, 0, 0, 0);
                if (l > 0) av = __builtin_amdgcn_mfma_f32_16x16x32_bf16(af[8], *(const pg8::bf16x8*)(LV + (size_t)col * 32 + 8 * q), av, 0, 0, 0);
#pragma unroll
                for (int i = 0; i < 4; ++i) {
                    const int o = (4 * q + i) * RWW + col;
                    outL[0 * 16 * RWW + o] = aw[i]; outL[1 * 16 * RWW + o] = aa[i]; outL[2 * 16 * RWW + o] = ag[i]; outL[3 * 16 * RWW + o] = av[i];
                }
            }
        }
        lds_barrier();
        if (tid < RWW) {
            const int c = tid, h = tid >> 6;
            const float w0c = p.in(9)[l * RWW + c], a0c = p.in(11)[l * RWW + c];
            const float v0c = l > 0 ? p.in(21)[lv * RWW + c] : 0.f;
            const float mur = mu[c], muk = mu[384 + c], muv = mu[768 + c];
            const float kkc = p.in(14)[l * RWW + c], kac = p.in(15)[l * RWW + c], rkc = p.in(16)[l * RWW + c];
            bf16_t rr_[17], kr_[17], vr_[17], vf_[16];
#pragma unroll
            for (int t = 0; t < 17; ++t) {
                const int tok = t0 - 1 + t;
                if (tok >= 0) { const bf16_t* qq = PR + (size_t)tok * PRW + c; rr_[t] = qq[0]; kr_[t] = qq[384]; vr_[t] = qq[768]; }
                else { rr_[t] = 0; kr_[t] = 0; vr_[t] = 0; }
            }
#pragma unroll
            for (int t = 0; t < 16; ++t) vf_[t] = (l > 0) ? VF[(size_t)(t0 + t) * RWW + c] : (bf16_t)0;
#pragma unroll
            for (int t = 0; t < 16; ++t) {
                const int tok = t0 + t;
                const float rc = bf2f(rr_[t + 1]), kc = bf2f(kr_[t + 1]), vc = bf2f(vr_[t + 1]);
                const float rp = bf2f(rr_[t]), kp = bf2f(kr_[t]), vp = bf2f(vr_[t]);
                const float r = rc + (rp - rc) * mur, k = kc + (kp - kc) * muk;
                float v = vc + (vp - vc) * muv;
                const size_t o = (size_t)tok * RWW + c;
                const float lw = w0c + outL[0 * 16 * RWW + t * RWW + c];
                const float a = sigm(a0c + outL[1 * 16 * RWW + t * RWW + c]);
                const float g = outL[2 * 16 * RWW + t * RWW + c];
                if (l == 0) VF[o] = f2bf(v);
                else { const float vf = bf2f(vf_[t]); v = v + (vf - v) * sigm(v0c + outL[3 * 16 * RWW + t * RWW + c]); }
                const float kk = k * kkc;
                const float n2 = wave_sum(kk * kk);
                const float kkn = kk * rsqrtf(fmaxf(n2, 1e-24f));
                const float kmod = k * (1.0f + (a - 1.0f) * kac);
                const float rks = wave_sum(r * kmod * rkc);
                Ww[o] = __expf(-0.60653066f * sigm(lw));
                Gg[o] = f2bf(g);
                Rr[o] = f2bf(r); Kk[o] = f2bf(kmod); Vv[o] = f2bf(v); Be[o] = f2bf(kkn); Al[o] = f2bf(kkn * a);
                if (lane == 0) RK[(size_t)tok * 8 + h] = rks;
            }
        }
    }
}

constexpr int TP = 40;
template <int KQ> __device__ __forceinline__ float kq_sum(float v) {
    v += dpp_mov<0xB1>(v); v += dpp_mov<0x4E>(v); v += dpp_mov<0x141>(v);
    if (KQ == 16) v += dpp_mov<0x140>(v);
    return v;
}

template <int pass>
__device__ __forceinline__ void rw_item(const Params& p, int l, int seg, int h, LAS float* sm, int tid, int lane, int wave) {
    unsigned char* ws = p.ws();
    const bf16_t* Rr = (const bf16_t*)(ws + WS_R); const bf16_t* Kk = (const bf16_t*)(ws + WS_K); const bf16_t* Vv = (const bf16_t*)(ws + WS_V);
    const bf16_t* Be = (const bf16_t*)(ws + WS_BE); const bf16_t* Al = (const bf16_t*)(ws + WS_AL); const bf16_t* Gg = (const bf16_t*)(ws + WS_G);
    const float* Ww = (const float*)(ws + WS_W); const float* RK = (const float*)(ws + WS_RK);
    float* Lm = (float*)(ws + WS_RWL); float* Pm = (float*)(ws + WS_RWP);
    bf16_t* MX = (bf16_t*)(ws + WS_H);
    const int kq = tid & 15, jp = tid >> 4, j0 = 2 * jp, j1 = 2 * jp + 1;
    f32x2 sA[2], sB[2], pA[2], pB[2];
#pragma unroll
    for (int i = 0; i < 2; ++i) {
        sA[i] = (f32x2){0.f, 0.f}; sB[i] = (f32x2){0.f, 0.f};
        pA[i] = (f32x2){(kq * 4 + 2 * i == j0) ? 1.f : 0.f, (kq * 4 + 2 * i + 1 == j0) ? 1.f : 0.f};
        pB[i] = (f32x2){(kq * 4 + 2 * i == j1) ? 1.f : 0.f, (kq * 4 + 2 * i + 1 == j1) ? 1.f : 0.f};
    }
    if (pass == 1 && seg > 0) {
        const float* q = Lm + ((size_t)((seg - 1) * 6 + h) * 64 + j0) * 64 + kq * 4;
        const f32x4 a = *(const f32x4*)q, b = *(const f32x4*)(q + 64);
        sA[0] = a.xy; sA[1] = a.zw; sB[0] = b.xy; sB[1] = b.zw;
    }
    float lnw = 0.f, lnb = 0.f;
    if (pass == 1) { lnw = p.in(17)[l * RWW + h * 64 + lane]; lnb = p.in(18)[l * RWW + h * 64 + lane]; }
    float rw_[2]; bf16_t rk_[2], ra_[2], rb_[2], rv_[2], rq_[2];
    const size_t gbase = (size_t)(seg * SEG) * RWW + h * 64 + (tid & 63);
    const int trow = tid >> 6;
#define RW_LOAD(sb) do { _Pragma("unroll") for (int e = 0; e < 2; ++e) { const size_t g = gbase + (size_t)((sb) * TS + trow + 8 * e) * RWW; \
        rw_[e] = Ww[g]; rk_[e] = Kk[g]; ra_[e] = Al[g]; rb_[e] = Be[g]; rv_[e] = Vv[g]; if (pass == 1) rq_[e] = Rr[g]; } } while (0)
#define RW_STORE(buf) do { _Pragma("unroll") for (int e = 0; e < 2; ++e) { LAS float* b_ = sm + (buf) * 6144 + tid + 512 * e; \
        b_[1024] = rw_[e]; b_[2048] = bf2f(rk_[e]); b_[3072] = bf2f(ra_[e]); b_[4096] = bf2f(rb_[e]); b_[5120] = bf2f(rv_[e]); if (pass == 1) b_[0] = bf2f(rq_[e]); } } while (0)
    lds_barrier();
    RW_LOAD(0); RW_STORE(0); RW_LOAD(1);
    lds_barrier();
    for (int sb = 0; sb < SEG / TS; ++sb) {
        const int cur = sb & 1;
        const LAS float* bf = sm + cur * 6144;
        LAS float* ob = sm + 12288 + cur * 1024;
        float pf_rk[2] = {0.f, 0.f}; bf16_t pf_v[2] = {0, 0}, pf_g[2] = {0, 0};
        if (pass == 1) {
#pragma unroll
            for (int rr = 0; rr < 2; ++rr) { const int tok = seg * SEG + sb * TS + wave + 8 * rr; const size_t g = (size_t)tok * RWW + h * 64 + lane; pf_rk[rr] = RK[(size_t)tok * 8 + h]; pf_v[rr] = Vv[g]; pf_g[rr] = Gg[g]; }
        }
        f32x4 nw4 = *(const LAS f32x4*)(bf + 1024 + kq * 4), nk4 = *(const LAS f32x4*)(bf + 2048 + kq * 4);
        f32x4 na4 = *(const LAS f32x4*)(bf + 3072 + kq * 4), nb4 = *(const LAS f32x4*)(bf + 4096 + kq * 4);
        f32x2 nvv = *(const LAS f32x2*)(bf + 5120 + j0);
        f32x4 nq4 = (pass == 1) ? *(const LAS f32x4*)(bf + kq * 4) : (f32x4){0.f, 0.f, 0.f, 0.f};
        f32x2 oacc[TS];
#pragma unroll
        for (int t = 0; t < TS; ++t) {
            const f32x4 w4 = nw4, k4 = nk4, a4 = na4, b4 = nb4, q4 = nq4; const f32x2 vv = nvv;
            {
                const int tn = (t + 1 < TS) ? t + 1 : t, on = tn * 64 + kq * 4;
                nw4 = *(const LAS f32x4*)(bf + 1024 + on); nk4 = *(const LAS f32x4*)(bf + 2048 + on);
                na4 = *(const LAS f32x4*)(bf + 3072 + on); nb4 = *(const LAS f32x4*)(bf + 4096 + on);
                nvv = *(const LAS f32x2*)(bf + 5120 + tn * 64 + j0);
                if (pass == 1) nq4 = *(const LAS f32x4*)(bf + on);
            }
            const f32x2 vA = {vv.x, vv.x}, vB = {vv.y, vv.y};
            f32x2 ua = b4.xy * sA[0], ub = b4.xy * sB[0];
            ua = b4.zw * sA[1] + ua; ub = b4.zw * sB[1] + ub;
            const float uA = kq_sum<16>(ua.x + ua.y), uB = kq_sum<16>(ub.x + ub.y);
            const f32x2 uA2 = {uA, uA}, uB2 = {uB, uB};
            { const f32x2 t0_ = k4.xy * vA - a4.xy * uA2, t1_ = k4.zw * vA - a4.zw * uA2; sA[0] = w4.xy * sA[0] + t0_; sA[1] = w4.zw * sA[1] + t1_; }
            { const f32x2 t0_ = k4.xy * vB - a4.xy * uB2, t1_ = k4.zw * vB - a4.zw * uB2; sB[0] = w4.xy * sB[0] + t0_; sB[1] = w4.zw * sB[1] + t1_; }
            if (pass == 0) {
                f32x2 qa = b4.xy * pA[0], qb = b4.xy * pB[0];
                qa = b4.zw * pA[1] + qa; qb = b4.zw * pB[1] + qb;
                const float gA = kq_sum<16>(qa.x + qa.y), gB = kq_sum<16>(qb.x + qb.y);
                const f32x2 gA2 = {gA, gA}, gB2 = {gB, gB};
                pA[0] = w4.xy * pA[0] - a4.xy * gA2; pA[1] = w4.zw * pA[1] - a4.zw * gA2;
                pB[0] = w4.xy * pB[0] - a4.xy * gB2; pB[1] = w4.zw * pB[1] - a4.zw * gB2;
            } else {
                f32x2 oa = q4.xy * sA[0], ob2 = q4.xy * sB[0];
                oa = q4.zw * sA[1] + oa; ob2 = q4.zw * sB[1] + ob2;
                const float oA = kq_sum<16>(oa.x + oa.y), oB = kq_sum<16>(ob2.x + ob2.y);
                oacc[t] = (f32x2){oA, oB};
            }
        }
        if (pass == 1 && kq == 0) {
#pragma unroll
            for (int t = 0; t < TS; ++t) *(LAS f32x2*)(ob + t * 64 + j0) = oacc[t];
        }
        if (sb + 1 < SEG / TS) RW_STORE(cur ^ 1);
        if (sb + 2 < SEG / TS) RW_LOAD(sb + 2);
        lds_barrier();
        if (pass == 1) {
            const int t0 = seg * SEG + sb * TS;
#pragma unroll
            for (int rr = 0; rr < 2; ++rr) {
                const int t = wave + 8 * rr, tok = t0 + t, c = h * 64 + lane;
                const float y = ob[t * 64 + lane];
                const float mean = wave_sum(y) * (1.0f / 64.0f);
                const float d = y - mean;
                const float var = wave_sum(d * d) * (1.0f / 64.0f);
                const float yn = d * rsqrtf(var + 64e-5f);
                const float val = yn * lnw + lnb + pf_rk[rr] * bf2f(pf_v[rr]);
                MX[(size_t)tok * D + c] = f2bf(val * bf2f(pf_g[rr]));
            }
        }
    }
#undef RW_LOAD
#undef RW_STORE
    if (pass == 0) {
        float* ql = Lm + ((size_t)(seg * 6 + h) * 64 + j0) * 64 + kq * 4;
        *(f32x4*)ql = (f32x4){sA[0].x, sA[0].y, sA[1].x, sA[1].y}; *(f32x4*)(ql + 64) = (f32x4){sB[0].x, sB[0].y, sB[1].x, sB[1].y};
        float* qp = Pm + ((size_t)(seg * 6 + h) * 64 + j0) * 64 + kq * 4;
        *(f32x4*)qp = (f32x4){pA[0].x, pA[0].y, pA[1].x, pA[1].y}; *(f32x4*)(qp + 64) = (f32x4){pB[0].x, pB[0].y, pB[1].x, pB[1].y};
    }
}

__device__ __forceinline__ float bf_at(const u32x4& a, const u32x4& b, int i) {
    const unsigned w = (i < 8) ? a[(i >> 1) & 3] : b[(i >> 1) & 3];
    return __uint_as_float((i & 1) ? (w & 0xffff0000u) : (w << 16));
}
#define DG_LOAD(sb) do { const int t0_ = seg * SEG + (sb) * TS; \
        if (HG) { _Pragma("unroll") for (int e = 0; e < EQ; ++e) { const int idx = tid + 512 * e; const bf16_t* row = PH + (size_t)(t0_ + (idx >> 7)) * PHG + h * 128 + (idx & 127); rf[e] = row[512]; if (pass == 1) rq[e] = row[0]; } \
                  _Pragma("unroll") for (int e = 0; e < EV; ++e) { const int idx = tid + 512 * e; rv[e] = PH[(size_t)(t0_ + (idx >> 6)) * PHG + 1024 + h * 64 + (idx & 63)]; } } \
        else { _Pragma("unroll") for (int e = 0; e < EQ; ++e) { const int idx = tid + 512 * e; if (idx < NQK) { const int t = idx / 48, c = idx % 48, tok = t0_ + t; \
                    _Pragma("unroll") for (int jj = 0; jj < 4; ++jj) { const int tt = tok - 3 + jj; bf16_t a = 0, b = 0; if (tt >= 0) { const bf16_t* row = PG + (size_t)tt * PGL + h * 48 + c; a = row[192]; if (pass == 1) b = row[0]; } ck[e][jj] = a; cq[e][jj] = b; } \
                    const u32x4* gp = (const u32x4*)(PG + (size_t)tok * PGL + 768); g0[e] = gp[0]; g1[e] = gp[1]; } } \
               _Pragma("unroll") for (int e = 0; e < EV; ++e) { const int idx = tid + 512 * e; const int t = idx / 96, c = idx % 96, tok = t0_ + t; \
                    _Pragma("unroll") for (int jj = 0; jj < 4; ++jj) { const int tt = tok - 3 + jj; bf16_t a = 0; if (tt >= 0) a = PG[(size_t)tt * PGL + 384 + h * 96 + c]; cv[e][jj] = a; } } } } while (0)
#define DG_STORE(buf) do { LAS float* b_ = sm + (buf) * 7680; \
        if (HG) { _Pragma("unroll") for (int e = 0; e < EQ; ++e) { const int idx = tid + 512 * e; const float f = bf2f(rf[e]); const float lb = sm[L_LB2 + (idx & 127)]; \
                    const float sg = __builtin_amdgcn_rcpf(1.0f + __expf(-f)); b_[2048 + idx] = fmaxf(lb + (1.0f - lb) * sg, 1e-30f); b_[4096 + idx] = (1.0f - lb) * (1.0f - sg); if (pass == 1) b_[idx] = silu(bf2f(rq[e])); } \
                  _Pragma("unroll") for (int e = 0; e < EV; ++e) b_[6144 + tid + 512 * e] = bf2f(rv[e]); } \
        else { _Pragma("unroll") for (int e = 0; e < EQ; ++e) { const int idx = tid + 512 * e; if (idx < NQK) { \
                    const int c_ = idx % 48; float aq = 0.f, ak = 0.f; _Pragma("unroll") for (int jj = 0; jj < 4; ++jj) { ak += sm[L_CW + jj * 192 + 48 + c_] * bf2f(ck[e][jj]); if (pass == 1) aq += sm[L_CW + jj * 192 + c_] * bf2f(cq[e][jj]); } \
                    float x = sm[L_GB + c_]; _Pragma("unroll") for (int i = 0; i < 16; ++i) x += bf_at(g0[e], g1[e], i) * sm[L_GUP + i * 48 + c_]; \
                    const float ls = fminf(x, 0.f) - __logf(1.0f + __expf(-fabsf(x))); \
                    b_[2048 + idx] = __expf(ls * (1.0f / 16.0f)); b_[4096 + idx] = silu(ak); if (pass == 1) b_[idx] = silu(aq) * 0.14433756729740643f; } } \
               _Pragma("unroll") for (int e = 0; e < EV; ++e) { const int c_ = (tid + 512 * e) % 96; float av = 0.f; _Pragma("unroll") for (int jj = 0; jj < 4; ++jj) av += sm[L_CW + jj * 192 + 96 + c_] * bf2f(cv[e][jj]); b_[6144 + tid + 512 * e] = silu(av); } } } while (0)

template <bool HG, int pass>
__device__ __forceinline__ void diag_item(const Params& p, int l, int seg, int h, LAS float* sm, int tid, int lane, int wave) {
    constexpr int K = HG ? 128 : 48, V = HG ? 64 : 96, KQ = HG ? 16 : 8, KPT = K / KQ, NP = KPT / 2;
    constexpr int NQK = TS * K, NV = TS * V, EQ = (NQK + 511) / 512, EV = (NV + 511) / 512;
    constexpr int L_LB2 = 18432;
    unsigned char* ws = p.ws();
    const bf16_t* PH = (const bf16_t*)(ws + WS_PHG); const bf16_t* PG = (const bf16_t*)(ws + WS_PGL);
    float* Lm = (float*)(ws + (HG ? WS_HGL : WS_GLL)); float* Dm = (float*)(ws + (HG ? WS_HGD : WS_GLD));
    bf16_t* MX = (bf16_t*)(ws + WS_H);
    const int kq = tid % KQ, jp = tid / KQ, j0 = 2 * jp;
    const bool active = j0 < V;
    f32x2 sA[NP], sB[NP], dt2[NP];
#pragma unroll
    for (int i = 0; i < NP; ++i) { sA[i] = (f32x2){0.f, 0.f}; sB[i] = (f32x2){0.f, 0.f}; dt2[i] = (f32x2){1.f, 1.f}; }
    if (pass == 1 && seg > 0 && active) {
        const float* q = Lm + ((size_t)((seg - 1) * 4 + h) * V + j0) * K + kq * KPT;
#pragma unroll
        for (int i = 0; i < NP; ++i) { sA[i] = *(const f32x2*)(q + 2 * i); sB[i] = *(const f32x2*)(q + K + 2 * i); }
    }
    float gn1 = 0.f, gn2 = 0.f;
    if (pass == 1) {
        if (HG) gn1 = p.in(24)[l * 256 + h * 64 + lane];
        else { gn1 = p.in(28)[l * 384 + h * 96 + lane]; gn2 = lane < 32 ? p.in(28)[l * 384 + h * 96 + 64 + lane] : 0.f; }
    }
    bf16_t rf[EQ], rq[EQ], rv[EV];
    bf16_t cq[EQ][4], ck[EQ][4], cv[EV][4];
    u32x4 g0[EQ], g1[EQ];
    constexpr int L_GUP = 18560, L_CW = 19328, L_GB = 20096;
    lds_barrier();
    if (HG) {
        if (tid < 128) {
            const float* lg = p.in(23) + h * 128 + tid;
            const float x0 = lg[0], x1 = lg[512], x2 = lg[1024], x3 = lg[1536];
            const float m = fmaxf(fmaxf(x0, x1), fmaxf(x2, x3));
            const float e0 = __expf(x0 - m), e1 = __expf(x1 - m), e2 = __expf(x2 - m), e3 = __expf(x3 - m);
            const float inv = 1.0f / (e0 + e1 + e2 + e3);
            float lb = 0.f;
            if (l >= 1) lb += e1; if (l >= 2) lb += e2; if (l >= 3) lb += e3;
            sm[L_LB2 + tid] = lb * inv;
        }
    } else {
        const float* cw = p.in(25) + (size_t)l * 4 * 768;
        for (int i = tid; i < 768; i += 512) { const int r = i / 48, c = i % 48; sm[L_GUP + i] = p.in(26)[(size_t)l * 16 * 192 + r * 192 + h * 48 + c]; }
        for (int i = tid; i < 768; i += 512) { const int jj = i / 192, c = i % 192; const int ch = c < 48 ? h * 48 + c : (c < 96 ? 192 + h * 48 + (c - 48) : 384 + h * 96 + (c - 96)); sm[L_CW + i] = cw[jj * 768 + ch]; }
        if (tid < 48) sm[L_GB + tid] = p.in(27)[l * 192 + h * 48 + tid];
    }
    DG_LOAD(0);
    lds_barrier();
    DG_STORE(0); DG_LOAD(1);
    lds_barrier();
    for (int sb = 0; sb < SEG / TS; ++sb) {
        const int cur = sb & 1;
        const LAS float* bf = sm + cur * 7680;
        LAS float* ob = sm + 15360 + cur * 1536;
        bf16_t pf_g1[2] = {0, 0}, pf_g2[2] = {0, 0};
        if (pass == 1) {
#pragma unroll
            for (int rr = 0; rr < 2; ++rr) { const int tok = seg * SEG + sb * TS + wave + 8 * rr;
                if (HG) pf_g1[rr] = PH[(size_t)tok * PHG + 1280 + h * 64 + lane];
                else { const bf16_t* row = PG + (size_t)tok * PGL + 784 + h * 96; pf_g1[rr] = row[lane]; pf_g2[rr] = lane < 32 ? row[64 + lane] : (bf16_t)0; } }
        }
        if (active) {
#pragma unroll 4
            for (int t = 0; t < TS; ++t) {
                const int o = t * K + kq * KPT;
                const f32x2 vv = *(const LAS f32x2*)(bf + 6144 + t * V + j0);
                const f32x2 vA = {vv.x, vv.x}, vB = {vv.y, vv.y};
                f32x2 dv[NP];
#pragma unroll
                for (int i = 0; i < NP; ++i) {
                    dv[i] = *(const LAS f32x2*)(bf + 2048 + o + 2 * i);
                    const f32x2 kk = *(const LAS f32x2*)(bf + 4096 + o + 2 * i);
                    sA[i] = dv[i] * sA[i] + kk * vA; sB[i] = dv[i] * sB[i] + kk * vB;
                }
                if (pass == 0) {
                    if (jp == 0) {
#pragma unroll
                        for (int i = 0; i < NP; ++i) dt2[i] = dt2[i] * dv[i];
                    }
                } else {
                    f32x2 oa = {0.f, 0.f}, ob2 = {0.f, 0.f};
#pragma unroll
                    for (int i = 0; i < NP; ++i) { const f32x2 q = *(const LAS f32x2*)(bf + o + 2 * i); oa = q * sA[i] + oa; ob2 = q * sB[i] + ob2; }
                    const float oA = kq_sum<KQ>(oa.x + oa.y), oB = kq_sum<KQ>(ob2.x + ob2.y);
                    if (kq == 0) *(LAS f32x2*)(ob + t * V + j0) = (f32x2){oA, oB};
                }
            }
        }
        if (sb + 1 < SEG / TS) DG_STORE(cur ^ 1);
        if (sb + 2 < SEG / TS) DG_LOAD(sb + 2);
        lds_barrier();
        if (pass == 1) {
            const int t0 = seg * SEG + sb * TS;
#pragma unroll
            for (int rr = 0; rr < 2; ++rr) {
                const int t = wave + 8 * rr, tok = t0 + t;
                if (HG) {
                    const float y = ob[t * 64 + lane];
                    const float ms = wave_sum(y * y) * (1.0f / 64.0f);
                    const float yn = y * rsqrtf(ms + 1e-5f);
                    MX[(size_t)tok * D + 384 + h * 64 + lane] = f2bf(yn * gn1 * silu(bf2f(pf_g1[rr])));
                } else {
                    const float y1 = ob[t * 96 + lane];
                    const float y2 = lane < 32 ? ob[t * 96 + 64 + lane] : 0.f;
                    const float ms = wave_sum(y1 * y1 + y2 * y2) * (1.0f / 96.0f);
                    const float rs = rsqrtf(ms + 1e-5f);
                    bf16_t* mo = MX + (size_t)tok * D + 640 + h * 96;
                    mo[lane] = f2bf(y1 * rs * gn1 * silu(bf2f(pf_g1[rr])));
                    if (lane < 32) mo[64 + lane] = f2bf(y2 * rs * gn2 * silu(bf2f(pf_g2[rr])));
                }
            }
        }
    }
    if (pass == 0 && active) {
        float* q = Lm + ((size_t)(seg * 4 + h) * V + j0) * K + kq * KPT;
#pragma unroll
        for (int i = 0; i < NP; ++i) { *(f32x2*)(q + 2 * i) = sA[i]; *(f32x2*)(q + K + 2 * i) = sB[i]; }
        if (jp == 0) {
            float* qd = Dm + (size_t)(seg * 4 + h) * K + kq * KPT;
#pragma unroll
            for (int i = 0; i < NP; ++i) *(f32x2*)(qd + 2 * i) = dt2[i];
        }
    }
}


template <bool HG>
__device__ __forceinline__ void diag_item_A(const Params& p, int l, int seg, int h, LAS float* sm, int tid, int lane, int wave) {
    constexpr int pass = 0;
    constexpr int K = HG ? 128 : 48, V = HG ? 64 : 96;
    constexpr int NQK = TS * K, NV = TS * V, EQ = (NQK + 511) / 512, EV = (NV + 511) / 512;
    constexpr int L_LB2 = 18432, L_GUP = 18560, L_CW = 19328, L_GB = 20096, L_KT = 20480, L_VT = 23040;
    unsigned char* ws = p.ws();
    const bf16_t* PH = (const bf16_t*)(ws + WS_PHG); const bf16_t* PG = (const bf16_t*)(ws + WS_PGL);
    float* Lm = (float*)(ws + (HG ? WS_HGL : WS_GLL)); float* Dm = (float*)(ws + (HG ? WS_HGD : WS_GLD));
    LAS bf16_t* kT = (LAS bf16_t*)(sm + L_KT); LAS bf16_t* vT = (LAS bf16_t*)(sm + L_VT);
    bf16_t rf[EQ], rq[EQ], rv[EV];
    bf16_t cq[EQ][4], ck[EQ][4], cv[EV][4];
    u32x4 g0[EQ], g1[EQ];
    lds_barrier();
    if (HG) {
        if (tid < 128) {
            const float* lg = p.in(23) + h * 128 + tid;
            const float x0 = lg[0], x1 = lg[512], x2 = lg[1024], x3 = lg[1536];
            const float m = fmaxf(fmaxf(x0, x1), fmaxf(x2, x3));
            const float e0 = __expf(x0 - m), e1 = __expf(x1 - m), e2 = __expf(x2 - m), e3 = __expf(x3 - m);
            const float inv = 1.0f / (e0 + e1 + e2 + e3);
            float lb = 0.f;
            if (l >= 1) lb += e1; if (l >= 2) lb += e2; if (l >= 3) lb += e3;
            sm[L_LB2 + tid] = lb * inv;
        }
    } else {
        const float* cw = p.in(25) + (size_t)l * 4 * 768;
        for (int i = tid; i < 768; i += 512) { const int r = i / 48, c = i % 48; sm[L_GUP + i] = p.in(26)[(size_t)l * 16 * 192 + r * 192 + h * 48 + c]; }
        for (int i = tid; i < 768; i += 512) { const int jj = i / 192, c = i % 192; const int ch = c < 48 ? h * 48 + c : (c < 96 ? 192 + h * 48 + (c - 48) : 384 + h * 96 + (c - 96)); sm[L_CW + i] = cw[jj * 768 + ch]; }
        if (tid < 48) sm[L_GB + tid] = p.in(27)[l * 192 + h * 48 + tid];
    }
    for (int i = tid; i < (L_VT - L_KT) + V * TP / 2; i += 512) ((LAS unsigned*)(sm + L_KT))[i] = 0u;
    float R = 1.0f;
    f32x4 acc[4];
#pragma unroll
    for (int i = 0; i < 4; ++i) acc[i] = (f32x4){0.f, 0.f, 0.f, 0.f};
    const int row = lane & 15, q = lane >> 4;
    DG_LOAD(7);
    lds_barrier();
    DG_STORE(1); DG_LOAD(6);
    lds_barrier();
    for (int sbi = 0; sbi < SEG / TS; ++sbi) {
        const int sb = SEG / TS - 1 - sbi, cur = sb & 1;
        const LAS float* bf = sm + cur * 7680;
        if (tid < K) {
            float dd[TS], kk_[TS];
#pragma unroll
            for (int t = 0; t < TS; ++t) { dd[t] = bf[2048 + t * K + tid]; kk_[t] = bf[4096 + t * K + tid]; }
#pragma unroll
            for (int t = TS - 1; t >= 0; --t) { kT[tid * TP + t] = f2bf(kk_[t] * R); R *= dd[t]; }
        }
        { float vv_[EV];
#pragma unroll
          for (int e = 0; e < EV; ++e) vv_[e] = bf[6144 + tid + 512 * e];
#pragma unroll
          for (int e = 0; e < EV; ++e) { const int idx = tid + 512 * e; vT[(idx % V) * TP + (idx / V)] = f2bf(vv_[e]); } }
        lds_barrier();
        if (HG) {
            const pg8::bf16x8 a = *(const LAS pg8::bf16x8*)(kT + (16 * wave + row) * TP + 8 * q);
#pragma unroll
            for (int n = 0; n < 4; ++n) acc[n] = __builtin_amdgcn_mfma_f32_16x16x32_bf16(a, *(const LAS pg8::bf16x8*)(vT + (16 * n + row) * TP + 8 * q), acc[n], 0, 0, 0);
        } else if (wave < 6) {
            const pg8::bf16x8 b = *(const LAS pg8::bf16x8*)(vT + (16 * wave + row) * TP + 8 * q);
#pragma unroll
            for (int m = 0; m < 3; ++m) acc[m] = __builtin_amdgcn_mfma_f32_16x16x32_bf16(*(const LAS pg8::bf16x8*)(kT + (16 * m + row) * TP + 8 * q), b, acc[m], 0, 0, 0);
        }
        if (sbi + 1 < SEG / TS) DG_STORE(cur ^ 1);
        if (sbi + 2 < SEG / TS) DG_LOAD(sb - 2);
        lds_barrier();
    }
    float* Lb = Lm + (size_t)(seg * 4 + h) * V * K;
    if (HG) {
#pragma unroll
        for (int n = 0; n < 4; ++n) *(f32x4*)(Lb + (size_t)(16 * n + row) * K + 16 * wave + 4 * q) = acc[n];
    } else if (wave < 6) {
#pragma unroll
        for (int m = 0; m < 3; ++m) *(f32x4*)(Lb + (size_t)(16 * wave + row) * K + 16 * m + 4 * q) = acc[m];
    }
    if (tid < K) Dm[(size_t)(seg * 4 + h) * K + tid] = R;
}

__device__ __forceinline__ void hg_item_C(const Params& p, int l, int seg, int h, LAS float* sm, int tid, int lane, int wave) {
    constexpr bool HG = true; constexpr int pass = 1;
    constexpr int K = 128, V = 64;
    constexpr int NQK = TS * K, NV = TS * V, EQ = (NQK + 511) / 512, EV = (NV + 511) / 512;
    constexpr int L_LB2 = 18432, L_GUP = 18560, L_CW = 19328, L_GB = 20096;
    constexpr int L_QG = 20480, L_KT = 21568, L_VT = 24128, L_AM = 25408, L_SB = 25728, L_G15 = 30080, L_PART = 30208;
    constexpr int QP = 136, SP = 136;
    (void)L_GUP; (void)L_CW; (void)L_GB;
    unsigned char* ws = p.ws();
    const bf16_t* PH = (const bf16_t*)(ws + WS_PHG); const bf16_t* PG = (const bf16_t*)(ws + WS_PGL);
    const float* Lm = (const float*)(ws + WS_HGL);
    bf16_t* MX = (bf16_t*)(ws + WS_H);
    LAS bf16_t* qG = (LAS bf16_t*)(sm + L_QG); LAS bf16_t* kT = (LAS bf16_t*)(sm + L_KT); LAS bf16_t* vT = (LAS bf16_t*)(sm + L_VT);
    LAS bf16_t* Am = (LAS bf16_t*)(sm + L_AM); LAS bf16_t* Sb = (LAS bf16_t*)(sm + L_SB);
    LAS float* G15 = sm + L_G15; LAS float* part = sm + L_PART;
    bf16_t rf[EQ], rq[EQ], rv[EV];
    bf16_t cq[EQ][4], ck[EQ][4], cv[EV][4];
    u32x4 g0[EQ], g1[EQ];
    const int row = lane & 15, q = lane >> 4;
    const float gn1 = p.in(24)[l * 256 + h * 64 + lane];
    lds_barrier();
    if (tid < 128) {
        const float* lg = p.in(23) + h * 128 + tid;
        const float x0 = lg[0], x1 = lg[512], x2 = lg[1024], x3 = lg[1536];
        const float m = fmaxf(fmaxf(x0, x1), fmaxf(x2, x3));
        const float e0 = __expf(x0 - m), e1 = __expf(x1 - m), e2 = __expf(x2 - m), e3 = __expf(x3 - m);
        const float inv = 1.0f / (e0 + e1 + e2 + e3);
        float lb = 0.f;
        if (l >= 1) lb += e1; if (l >= 2) lb += e2; if (l >= 3) lb += e3;
        sm[L_LB2 + tid] = lb * inv;
    }
    for (int i = tid; i < (L_SB - L_KT); i += 512) ((LAS unsigned*)(sm + L_KT))[i] = 0u;
    f32x4 S[4];
    {
        const float* Lb = Lm + (size_t)((seg > 0 ? seg - 1 : 0) * 4 + h) * V * K;
#pragma unroll
        for (int n = 0; n < 4; ++n) S[n] = (seg > 0) ? *(const f32x4*)(Lb + (size_t)(16 * n + row) * K + 16 * wave + 4 * q) : (f32x4){0.f, 0.f, 0.f, 0.f};
#pragma unroll
        for (int n = 0; n < 4; ++n) { u32x2 w; w.x = pk2(S[n][0], S[n][1]); w.y = pk2(S[n][2], S[n][3]); *(LAS u32x2*)(Sb + (16 * n + row) * SP + 16 * wave + 4 * q) = w; }
    }
    DG_LOAD(0);
    lds_barrier();
    DG_STORE(0); DG_LOAD(1);
    lds_barrier();
    for (int sb = 0; sb < SEG / TS; ++sb) {
        const int cur = sb & 1;
        const LAS float* bf = sm + cur * 7680;
        LAS float* ob = sm + 15360 + cur * 1536;
        bf16_t pf_g1[2];
#pragma unroll
        for (int rr = 0; rr < 2; ++rr) { const int tok = seg * SEG + sb * TS + wave + 8 * rr; pf_g1[rr] = PH[(size_t)tok * PHG + 1280 + h * 64 + lane]; }
        if (tid < 256) {
            const int j = tid >> 4, sl = tid & 15;
            f32x4 z0 = *(const LAS f32x4*)(bf + 4096 + j * K + 8 * sl), z1 = *(const LAS f32x4*)(bf + 4096 + j * K + 8 * sl + 4);
            f32x4 na0 = *(const LAS f32x4*)(bf + j * K + 8 * sl), na1 = *(const LAS f32x4*)(bf + j * K + 8 * sl + 4);
            const int tj1 = (j + 1 < TS) ? j + 1 : j;
            f32x4 nd0 = *(const LAS f32x4*)(bf + 2048 + tj1 * K + 8 * sl), nd1 = *(const LAS f32x4*)(bf + 2048 + tj1 * K + 8 * sl + 4);
            for (int t = j; t < TS; ++t) {
                const f32x4 a0 = na0, a1 = na1, d0 = nd0, d1 = nd1;
                { const int tn = (t + 1 < TS) ? t + 1 : t, tn2 = (t + 2 < TS) ? t + 2 : TS - 1;
                  na0 = *(const LAS f32x4*)(bf + tn * K + 8 * sl); na1 = *(const LAS f32x4*)(bf + tn * K + 8 * sl + 4);
                  nd0 = *(const LAS f32x4*)(bf + 2048 + tn2 * K + 8 * sl); nd1 = *(const LAS f32x4*)(bf + 2048 + tn2 * K + 8 * sl + 4); }
                part[(t * 16 + j) * 16 + sl] = (a0.x * z0.x + a0.y * z0.y) + (a0.z * z0.z + a0.w * z0.w) + (a1.x * z1.x + a1.y * z1.y) + (a1.z * z1.z + a1.w * z1.w);
                z0 = z0 * d0; z1 = z1 * d1;
            }
        } else if (tid < 384) {
            const int c = tid - 256;
            float dd[TS], qq[TS], kk_[TS];
#pragma unroll
            for (int t = 0; t < TS; ++t) { dd[t] = bf[2048 + t * K + c]; qq[t] = bf[t * K + c]; kk_[t] = bf[4096 + t * K + c]; }
            float G = 1.0f;
#pragma unroll
            for (int t = 0; t < TS; ++t) { G *= dd[t]; qG[t * QP + c] = f2bf(qq[t] * G); }
            G15[c] = G;
            float H = 1.0f;
#pragma unroll
            for (int t = TS - 1; t >= 0; --t) { kT[c * TP + t] = f2bf(kk_[t] * H); H *= dd[t]; }
        } else {
            float vv_[8];
#pragma unroll
            for (int e = 0; e < 8; ++e) vv_[e] = bf[6144 + (tid - 384) + 128 * e];
#pragma unroll
            for (int e = 0; e < 8; ++e) { const int idx = (tid - 384) + 128 * e; vT[(idx & 63) * TP + (idx >> 6)] = f2bf(vv_[e]); }
        }
        lds_barrier();
        if (tid < 256) {
            const int t = tid >> 4, j = tid & 15;
            float a = 0.f;
            if (j <= t) {
                const LAS f32x4* pp = (const LAS f32x4*)(part + (t * 16 + j) * 16);
                const f32x4 x0 = pp[0], x1 = pp[1], x2 = pp[2], x3 = pp[3];
                a = ((x0.x + x0.y) + (x0.z + x0.w)) + ((x1.x + x1.y) + (x1.z + x1.w)) + ((x2.x + x2.y) + (x2.z + x2.w)) + ((x3.x + x3.y) + (x3.z + x3.w));
            }
            Am[t * TP + j] = f2bf(a);
        }
        lds_barrier();
        if (wave < 4) {
            f32x4 o = {0.f, 0.f, 0.f, 0.f};
#pragma unroll
            for (int kc = 0; kc < 4; ++kc)
                o = __builtin_amdgcn_mfma_f32_16x16x32_bf16(*(const LAS pg8::bf16x8*)(qG + row * QP + 32 * kc + 8 * q), *(const LAS pg8::bf16x8*)(Sb + (16 * wave + row) * SP + 32 * kc + 8 * q), o, 0, 0, 0);
            o = __builtin_amdgcn_mfma_f32_16x16x32_bf16(*(const LAS pg8::bf16x8*)(Am + row * TP + 8 * q), *(const LAS pg8::bf16x8*)(vT + (16 * wave + row) * TP + 8 * q), o, 0, 0, 0);
#pragma unroll
            for (int i = 0; i < 4; ++i) ob[(4 * q + i) * 64 + 16 * wave + row] = o[i];
        }
        {
            const f32x4 gg = *(const LAS f32x4*)(G15 + 16 * wave + 4 * q);
            const pg8::bf16x8 a = *(const LAS pg8::bf16x8*)(kT + (16 * wave + row) * TP + 8 * q);
#pragma unroll
            for (int n = 0; n < 4; ++n) S[n] = __builtin_amdgcn_mfma_f32_16x16x32_bf16(a, *(const LAS pg8::bf16x8*)(vT + (16 * n + row) * TP + 8 * q), S[n] * gg, 0, 0, 0);
        }
        lds_barrier();
#pragma unroll
        for (int n = 0; n < 4; ++n) { u32x2 w; w.x = pk2(S[n][0], S[n][1]); w.y = pk2(S[n][2], S[n][3]); *(LAS u32x2*)(Sb + (16 * n + row) * SP + 16 * wave + 4 * q) = w; }
#pragma unroll
        for (int rr = 0; rr < 2; ++rr) {
            const int t = wave + 8 * rr, tok = seg * SEG + sb * TS + t;
            const float y = ob[t * 64 + lane];
            const float ms = wave_sum(y * y) * (1.0f / 64.0f);
            const float yn = y * rsqrtf(ms + 1e-5f);
            MX[(size_t)tok * D + 384 + h * 64 + lane] = f2bf(yn * gn1 * silu(bf2f(pf_g1[rr])));
        }
        if (sb + 1 < SEG / TS) DG_STORE(cur ^ 1);
        if (sb + 2 < SEG / TS) DG_LOAD(sb + 2);
        lds_barrier();
    }
}

__device__ __forceinline__ void gl_item_C(const Params& p, int l, int seg, int h, LAS float* sm, int tid, int lane, int wave) {
    constexpr bool HG = false; constexpr int pass = 1;
    constexpr int K = 48, V = 96;
    constexpr int NQK = TS * K, NV = TS * V, EQ = (NQK + 511) / 512, EV = (NV + 511) / 512;
    constexpr int L_LB2 = 18432, L_GUP = 18560, L_CW = 19328, L_GB = 20096;
    constexpr int L_QG = 20480, L_KT = 21056, L_VT = 22016, L_AM = 23936, L_SB = 24256, L_G15 = 27712, L_PART = 27776;
    constexpr int QP = 72, SP = 72;
    (void)L_LB2;
    unsigned char* ws = p.ws();
    const bf16_t* PH = (const bf16_t*)(ws + WS_PHG); const bf16_t* PG = (const bf16_t*)(ws + WS_PGL);
    const float* Lm = (const float*)(ws + WS_GLL);
    bf16_t* MX = (bf16_t*)(ws + WS_H);
    LAS bf16_t* qG = (LAS bf16_t*)(sm + L_QG); LAS bf16_t* kT = (LAS bf16_t*)(sm + L_KT); LAS bf16_t* vT = (LAS bf16_t*)(sm + L_VT);
    LAS bf16_t* Am = (LAS bf16_t*)(sm + L_AM); LAS bf16_t* Sb = (LAS bf16_t*)(sm + L_SB);
    LAS float* G15 = sm + L_G15; LAS float* part = sm + L_PART;
    bf16_t rf[EQ], rq[EQ], rv[EV];
    bf16_t cq[EQ][4], ck[EQ][4], cv[EV][4];
    u32x4 g0[EQ], g1[EQ];
    const int row = lane & 15, q = lane >> 4;
    const float gn1 = p.in(28)[l * 384 + h * 96 + lane], gn2 = lane < 32 ? p.in(28)[l * 384 + h * 96 + 64 + lane] : 0.f;
    lds_barrier();
    {
        const float* cw = p.in(25) + (size_t)l * 4 * 768;
        for (int i = tid; i < 768; i += 512) { const int r = i / 48, c = i % 48; sm[L_GUP + i] = p.in(26)[(size_t)l * 16 * 192 + r * 192 + h * 48 + c]; }
        for (int i = tid; i < 768; i += 512) { const int jj = i / 192, c = i % 192; const int ch = c < 48 ? h * 48 + c : (c < 96 ? 192 + h * 48 + (c - 48) : 384 + h * 96 + (c - 96)); sm[L_CW + i] = cw[jj * 768 + ch]; }
        if (tid < 48) sm[L_GB + tid] = p.in(27)[l * 192 + h * 48 + tid];
    }
    for (int i = tid; i < (L_G15 - L_QG); i += 512) ((LAS unsigned*)(sm + L_QG))[i] = 0u;
    lds_barrier();
    f32x4 S[3];
#pragma unroll
    for (int m = 0; m < 3; ++m) S[m] = (f32x4){0.f, 0.f, 0.f, 0.f};
    if (wave < 6) {
        const float* Lb = Lm + (size_t)((seg > 0 ? seg - 1 : 0) * 4 + h) * V * K;
        if (seg > 0) {
#pragma unroll
            for (int m = 0; m < 3; ++m) S[m] = *(const f32x4*)(Lb + (size_t)(16 * wave + row) * K + 16 * m + 4 * q);
        }
#pragma unroll
        for (int m = 0; m < 3; ++m) { u32x2 w; w.x = pk2(S[m][0], S[m][1]); w.y = pk2(S[m][2], S[m][3]); *(LAS u32x2*)(Sb + (16 * wave + row) * SP + 16 * m + 4 * q) = w; }
    }
    DG_LOAD(0);
    lds_barrier();
    DG_STORE(0); DG_LOAD(1);
    lds_barrier();
    for (int sb = 0; sb < SEG / TS; ++sb) {
        const int cur = sb & 1;
        const LAS float* bf = sm + cur * 7680;
        LAS float* ob = sm + 15360 + cur * 1536;
        bf16_t pf_g1[2], pf_g2[2];
#pragma unroll
        for (int rr = 0; rr < 2; ++rr) { const int tok = seg * SEG + sb * TS + wave + 8 * rr; const bf16_t* rowp = PG + (size_t)tok * PGL + 784 + h * 96; pf_g1[rr] = rowp[lane]; pf_g2[rr] = lane < 32 ? rowp[64 + lane] : (bf16_t)0; }
        if (tid < 256) {
            const int j = tid >> 4, sl = tid & 15;
            float z0 = bf[4096 + j * K + 3 * sl], z1 = bf[4096 + j * K + 3 * sl + 1], z2 = bf[4096 + j * K + 3 * sl + 2];
            float nq0 = bf[j * K + 3 * sl], nq1 = bf[j * K + 3 * sl + 1], nq2 = bf[j * K + 3 * sl + 2];
            const int tj1 = (j + 1 < TS) ? j + 1 : j;
            float nd0 = bf[2048 + tj1 * K + 3 * sl], nd1 = bf[2048 + tj1 * K + 3 * sl + 1], nd2 = bf[2048 + tj1 * K + 3 * sl + 2];
            for (int t = j; t < TS; ++t) {
                const float q0 = nq0, q1 = nq1, q2 = nq2, d0 = nd0, d1 = nd1, d2 = nd2;
                { const int tn = (t + 1 < TS) ? t + 1 : t, tn2 = (t + 2 < TS) ? t + 2 : TS - 1;
                  const LAS float* qp = bf + tn * K + 3 * sl; nq0 = qp[0]; nq1 = qp[1]; nq2 = qp[2];
                  const LAS float* dp = bf + 2048 + tn2 * K + 3 * sl; nd0 = dp[0]; nd1 = dp[1]; nd2 = dp[2]; }
                part[(t * 16 + j) * 16 + sl] = q0 * z0 + q1 * z1 + q2 * z2;
                z0 *= d0; z1 *= d1; z2 *= d2;
            }
        } else if (tid < 256 + K) {
            const int c = tid - 256;
            float dd[TS], qq[TS], kk_[TS];
#pragma unroll
            for (int t = 0; t < TS; ++t) { dd[t] = bf[2048 + t * K + c]; qq[t] = bf[t * K + c]; kk_[t] = bf[4096 + t * K + c]; }
            float G = 1.0f;
#pragma unroll
            for (int t = 0; t < TS; ++t) { G *= dd[t]; qG[t * QP + c] = f2bf(qq[t] * G); }
            G15[c] = G;
            float H = 1.0f;
#pragma unroll
            for (int t = TS - 1; t >= 0; --t) { kT[c * TP + t] = f2bf(kk_[t] * H); H *= dd[t]; }
        } else if (tid >= 384) {
            float vv_[12];
#pragma unroll
            for (int e = 0; e < 12; ++e) vv_[e] = bf[6144 + (tid - 384) + 128 * e];
#pragma unroll
            for (int e = 0; e < 12; ++e) { const int idx = (tid - 384) + 128 * e; vT[(idx % V) * TP + (idx / V)] = f2bf(vv_[e]); }
        }
        lds_barrier();
        if (tid < 256) {
            const int t = tid >> 4, j = tid & 15;
            float a = 0.f;
            if (j <= t) {
                const LAS f32x4* pp = (const LAS f32x4*)(part + (t * 16 + j) * 16);
                const f32x4 x0 = pp[0], x1 = pp[1], x2 = pp[2], x3 = pp[3];
                a = ((x0.x + x0.y) + (x0.z + x0.w)) + ((x1.x + x1.y) + (x1.z + x1.w)) + ((x2.x + x2.y) + (x2.z + x2.w)) + ((x3.x + x3.y) + (x3.z + x3.w));
            }
            Am[t * TP + j] = f2bf(a);
        }
        lds_barrier();
        if (wave < 6) {
            f32x4 o = {0.f, 0.f, 0.f, 0.f};
#pragma unroll
            for (int kc = 0; kc < 2; ++kc)
                o = __builtin_amdgcn_mfma_f32_16x16x32_bf16(*(const LAS pg8::bf16x8*)(qG + row * QP + 32 * kc + 8 * q), *(const LAS pg8::bf16x8*)(Sb + (16 * wave + row) * SP + 32 * kc + 8 * q), o, 0, 0, 0);
            const pg8::bf16x8 vb = *(const LAS pg8::bf16x8*)(vT + (16 * wave + row) * TP + 8 * q);
            o = __builtin_amdgcn_mfma_f32_16x16x32_bf16(*(const LAS pg8::bf16x8*)(Am + row * TP + 8 * q), vb, o, 0, 0, 0);
#pragma unroll
            for (int i = 0; i < 4; ++i) ob[(4 * q + i) * 96 + 16 * wave + row] = o[i];
#pragma unroll
            for (int m = 0; m < 3; ++m) {
                const f32x4 gg = *(const LAS f32x4*)(G15 + 16 * m + 4 * q);
                S[m] = __builtin_amdgcn_mfma_f32_16x16x32_bf16(*(const LAS pg8::bf16x8*)(kT + (16 * m + row) * TP + 8 * q), vb, S[m] * gg, 0, 0, 0);
            }
        }
        lds_barrier();
        if (wave < 6) {
#pragma unroll
            for (int m = 0; m < 3; ++m) { u32x2 w; w.x = pk2(S[m][0], S[m][1]); w.y = pk2(S[m][2], S[m][3]); *(LAS u32x2*)(Sb + (16 * wave + row) * SP + 16 * m + 4 * q) = w; }
        }
#pragma unroll
        for (int rr = 0; rr < 2; ++rr) {
            const int t = wave + 8 * rr, tok = seg * SEG + sb * TS + t;
            const float y1 = ob[t * 96 + lane];
            const float y2 = lane < 32 ? ob[t * 96 + 64 + lane] : 0.f;
            const float ms = wave_sum(y1 * y1 + y2 * y2) * (1.0f / 96.0f);
            const float rs = rsqrtf(ms + 1e-5f);
            bf16_t* mo = MX + (size_t)tok * D + 640 + h * 96;
            mo[lane] = f2bf(y1 * rs * gn1 * silu(bf2f(pf_g1[rr])));
            if (lane < 32) mo[64 + lane] = f2bf(y2 * rs * gn2 * silu(bf2f(pf_g2[rr])));
        }
        if (sb + 1 < SEG / TS) DG_STORE(cur ^ 1);
        if (sb + 2 < SEG / TS) DG_LOAD(sb + 2);
        lds_barrier();
    }
}
#undef DG_LOAD
#undef DG_STORE

template <int pass>
__device__ __forceinline__ void phase_scan(const Params& p, int l, LAS unsigned char* lds, int tid, int lane, int wave) {
    LAS float* sm = (LAS float*)lds;
    constexpr int N_RW = NSEG * 6, N_HG = NSEG * 4, N_GL = NSEG * 4;
    for (int it = blockIdx.x; it < N_RW + N_HG + N_GL; it += gridDim.x) {
        asm volatile("" : "+v"(tid));
        lane = tid & 63; wave = __builtin_amdgcn_readfirstlane(tid >> 6);
        if (it < N_RW) rw_item<pass>(p, l, it / 6, it % 6, sm, tid, lane, wave);
        else if (it < N_RW + N_HG) { if constexpr (pass == 0) diag_item_A<true>(p, l, (it - N_RW) / 4, (it - N_RW) % 4, sm, tid, lane, wave); else hg_item_C(p, l, (it - N_RW) / 4, (it - N_RW) % 4, sm, tid, lane, wave); }
        else { if constexpr (pass == 0) diag_item_A<false>(p, l, (it - N_RW - N_HG) / 4, (it - N_RW - N_HG) % 4, sm, tid, lane, wave); else gl_item_C(p, l, (it - N_RW - N_HG) / 4, (it - N_RW - N_HG) % 4, sm, tid, lane, wave); }
    }
}

__device__ __forceinline__ void phase_combine(const Params& p, LAS unsigned char* lds, int tid, int lane, int wave, bool dummy) {
    unsigned char* ws = p.ws();
    for (int b = blockIdx.x; b < 124; b += gridDim.x) {
        if (b < 24) {
            const int head = b >> 2, nt = b & 3, row = lane & 15, q = lane >> 4;
            float* Lm = (float*)(ws + WS_RWL); const float* Pm = (const float*)(ws + WS_RWP);
            LAS float* buf = (LAS float*)lds;
            LAS float* sbuf = buf + 8192;
            constexpr size_t SS = 6 * 4096;
            const float* pbase = Pm + (size_t)head * 4096 + tid * 8;
            const int wv = wave & 3;
            float* lbase = Lm + ((size_t)head * 64 + 16 * nt + row) * 64 + 16 * wv + 4 * q;
            float* sbase = (dummy ? (float*)(ws + WS_H) : Lm) + ((size_t)head * 64 + 16 * nt + row) * 64 + 16 * wv + 4 * q;
            f32x4 pr[6][2]; f32x4 lq[6];
            lds_barrier();
            { const f32x4* qq = (const f32x4*)pbase; const f32x4 a = qq[0], c = qq[1]; *(LAS f32x4*)(buf + tid * 8) = a; *(LAS f32x4*)(buf + tid * 8 + 4) = c; }
            for (int i = tid; i < 2048; i += 512) sbuf[i] = 0.f;
#pragma unroll
            for (int u = 0; u < 6; ++u) {
                const f32x4* qq = (const f32x4*)(pbase + (size_t)(1 + u) * SS); pr[u][0] = qq[0]; pr[u][1] = qq[1];
                lq[u] = *(const f32x4*)(lbase + (size_t)u * SS);
            }
            lds_barrier();
#define CB_STEP(seg, u, REFILL) do { \
                LAS float* wb = buf + (((seg) + 1) & 1) * 4096 + tid * 8; \
                *(LAS f32x4*)wb = pr[u][0]; *(LAS f32x4*)(wb + 4) = pr[u][1]; \
                f32x4 acc = lq[u]; \
                if (REFILL) { const int sn = ((seg) + 7 < NSEG - 1) ? (seg) + 7 : NSEG - 2; const f32x4* qq = (const f32x4*)(pbase + (size_t)sn * SS); pr[u][0] = qq[0]; pr[u][1] = qq[1]; \
                  const int ln = ((seg) + 6 < NSEG - 1) ? (seg) + 6 : NSEG - 2; lq[u] = *(const f32x4*)(lbase + (size_t)ln * SS); } \
                if (wave < 4) { \
                    const LAS float* pa = buf + ((seg) & 1) * 4096 + q * 64 + 16 * wv + row;        \
                    const LAS float* pb = sbuf + ((seg) & 1) * 1024 + q * 16 + row;                 \
                    float av_[16], bv_[16]; \
                    _Pragma("unroll") for (int s_ = 0; s_ < 16; ++s_) { av_[s_] = pa[s_ * 256]; bv_[s_] = pb[s_ * 64]; } \
                    asm volatile("s_waitcnt lgkmcnt(0)" ::: "memory");        \
                    f32x4 acc2 = {0.f, 0.f, 0.f, 0.f}; \
                    _Pragma("unroll") for (int s_ = 0; s_ < 16; s_ += 2) { acc = __builtin_amdgcn_mfma_f32_16x16x4f32(av_[s_], bv_[s_], acc, 0, 0, 0); acc2 = __builtin_amdgcn_mfma_f32_16x16x4f32(av_[s_ + 1], bv_[s_ + 1], acc2, 0, 0, 0); } \
                    acc = acc + acc2; \
                    *(f32x4*)(sbase + (size_t)(seg) * SS) = acc; \
                    LAS float* sw = sbuf + (((seg) + 1) & 1) * 1024 + (16 * wv + 4 * q) * 16 + row; \
                    sw[0] = acc[0]; sw[16] = acc[1]; sw[32] = acc[2]; sw[48] = acc[3]; \
                } \
                lds_barrier(); } while (0)
            for (int seg0 = 0; seg0 < 126; seg0 += 6) {
                CB_STEP(seg0 + 0, 0, true); CB_STEP(seg0 + 1, 1, true); CB_STEP(seg0 + 2, 2, true);
                CB_STEP(seg0 + 3, 3, true); CB_STEP(seg0 + 4, 4, true); CB_STEP(seg0 + 5, 5, true);
            }
            CB_STEP(126, 0, false);
#undef CB_STEP
            static_assert(NSEG == 128, "combine schedule");
        } else {
            int e = (b - 24) * 512 + tid;
            float* Lm; const float* Dm; size_t lstride, dstride; size_t lo, dof;
            if (e < 4 * 8192) { const int h = e / 8192, rem = e % 8192, c = rem % 128; Lm = (float*)(ws + WS_HGL); Dm = (const float*)(ws + WS_HGD); lstride = 4 * 8192; dstride = 4 * 128; lo = (size_t)h * 8192 + rem; dof = (size_t)h * 128 + c; }
            else { e -= 4 * 8192; const int h = e / 4608, rem = e % 4608, c = rem % 48; Lm = (float*)(ws + WS_GLL); Dm = (const float*)(ws + WS_GLD); lstride = 4 * 4608; dstride = 4 * 48; lo = (size_t)h * 4608 + rem; dof = (size_t)h * 48 + c; }
            float s = 0.f;
            float* Ls = Lm;
            if (dummy) { if (e >= 0 && Lm == (float*)(ws + WS_HGL)) Ls = (float*)(ws + WS_H) + 3145728; else continue; }
            for (int s0 = 0; s0 < NSEG - 1; s0 += 32) {
                float lv[32], dv[32];
#pragma unroll
                for (int i = 0; i < 32; ++i) { const int sg = (s0 + i < NSEG - 1) ? s0 + i : NSEG - 2; lv[i] = Lm[(size_t)sg * lstride + lo]; dv[i] = Dm[(size_t)sg * dstride + dof]; }
#pragma unroll
                for (int i = 0; i < 32; ++i) if (s0 + i < NSEG - 1) { s = dv[i] * s + lv[i]; Ls[(size_t)(s0 + i) * lstride + lo] = s; }
            }
        }
    }
}

#define XB_TMO      128
#define XB_XCNT(j)  (256  + 64 * (j))
#define XB_XSUB(j)  (1280 + 64 * (j))
#define XB_XGEN(j)  (2304 + 64 * (j))
#define XB_TOP      3328
#define XB_TOPGEN   3392
#define XCD_BAR_WORDS 3456
#define XB_SPIN_CAP (1u << 18)

__device__ __forceinline__ unsigned xb_ld(unsigned* p)              { return __hip_atomic_load(p, __ATOMIC_RELAXED, __HIP_MEMORY_SCOPE_AGENT); }
__device__ __forceinline__ unsigned xb_add(unsigned* p, unsigned v) { return __hip_atomic_fetch_add(p, v, __ATOMIC_RELAXED, __HIP_MEMORY_SCOPE_AGENT); }
__device__ __forceinline__ unsigned xb_xcc_id() { return (unsigned)__builtin_amdgcn_s_getreg((3 << 11) | 20) & 0xFu; }
#define XB_SPIN(cond, bar) do { unsigned _sp = 0; while (cond) { __builtin_amdgcn_s_sleep(1); \
    if ((++_sp & 255u) == 0u) { if (xb_ld(&(bar)[XB_TMO])) break; if (_sp > XB_SPIN_CAP) { atomicAdd(&(bar)[XB_TMO], 1u); break; } } } } while (0)

struct XcdBarrier {
    unsigned* bar; unsigned x;
    volatile LAS unsigned* st;
};

__device__ __forceinline__ XcdBarrier xcd_barrier_post(unsigned* bar, volatile LAS unsigned* st) {
    XcdBarrier b; b.bar = bar; b.x = xb_xcc_id(); b.st = st;
    if (threadIdx.x == 0) (void)xb_add(&bar[XB_XCNT(b.x)], 1u);
    return b;
}
__device__ __forceinline__ void xcd_barrier_complete(unsigned* bar, unsigned x, unsigned& nloc, unsigned& nx) {
    const unsigned G = gridDim.x * gridDim.y * gridDim.z;
    unsigned sum, cnt, mine, sp = 0u;
    for (;;) {
        sum = 0u; cnt = 0u; mine = 0u;
#pragma unroll
        for (unsigned j = 0; j < 16; ++j) { const unsigned c = xb_ld(&bar[XB_XCNT(j)]); sum += c; cnt += (c > 0u) ? 1u : 0u; mine = (j == x) ? c : mine; }
        if (sum == G) break;
        __builtin_amdgcn_s_sleep(1);
        if ((++sp & 255u) == 0u) { if (xb_ld(&bar[XB_TMO])) break; if (sp > XB_SPIN_CAP) { atomicAdd(&bar[XB_TMO], 1u); break; } }
    }
    nloc = mine > 0u ? mine : 1u; nx = cnt > 0u ? cnt : 1u;
}

__device__ __forceinline__ void xcd_barrier(const XcdBarrier& b) {
    asm volatile("s_waitcnt vmcnt(0)" ::: "memory");
    __syncthreads();
    if (threadIdx.x == 0) {
        unsigned* bar = b.bar;
        __builtin_amdgcn_s_waitcnt(0);
        unsigned nloc = b.st[0], nx = b.st[1];
        if (nloc == 0u) { xcd_barrier_complete(bar, b.x, nloc, nx); b.st[0] = nloc; b.st[1] = nx; }
        const unsigned old = xb_add(&bar[XB_XSUB(b.x)], 1u);
        const unsigned gen = old / nloc;
        if (old + 1u == (gen + 1u) * nloc) {
            __builtin_amdgcn_fence(__ATOMIC_RELEASE, "agent");
            asm volatile("s_waitcnt vmcnt(0)" ::: "memory");
            const unsigned og = xb_add(&bar[XB_TOP], 1u);
            const unsigned tg = og / nx;
            if (og + 1u == (tg + 1u) * nx) xb_add(&bar[XB_TOPGEN], 1u);
            else XB_SPIN(xb_ld(&bar[XB_TOPGEN]) == tg, bar);
            __builtin_amdgcn_fence(__ATOMIC_ACQUIRE, "agent");
            xb_add(&bar[XB_XGEN(b.x)], 1u);
            asm volatile("s_waitcnt vmcnt(0)" ::: "memory");
        } else {
            XB_SPIN(xb_ld(&bar[XB_XGEN(b.x)]) == gen, bar);
            __builtin_amdgcn_fence(__ATOMIC_ACQUIRE, "agent");
            asm volatile("s_waitcnt vmcnt(0)" ::: "memory");
        }
    }
    __syncthreads();
}

__global__ void __launch_bounds__(512, 2) mega_fwd(KArgs ka) {
    extern __shared__ __attribute__((aligned(16))) unsigned char lds_raw[];
    LAS unsigned char* lds = (LAS unsigned char*)lds_raw;
    cg::grid_group grid = cg::this_grid();
    const int G = gridDim.x, ngw = G * 8;
    if (threadIdx.x == 0) {
        LAS unsigned long long* t = (LAS unsigned long long*)(lds + TBL_OFF);
#pragma unroll
        for (int i = 0; i < 34; ++i) t[i] = (unsigned long long)ka.in[i];
        t[34] = (unsigned long long)ka.out; t[35] = (unsigned long long)ka.ws;
    }
    if (blockIdx.x == 0) { unsigned* bw = (unsigned*)(ka.ws + WS_BAR); for (int i = threadIdx.x; i < XCD_BAR_WORDS; i += 512) bw[i] = 0u; }
    if (threadIdx.x < 4) ((LAS unsigned*)(lds + TBL_OFF + 512))[threadIdx.x] = 0u;
    XcdBarrier xbar; xbar.bar = (unsigned*)(ka.ws + WS_BAR); xbar.x = 0; xbar.st = (volatile LAS unsigned*)(lds + TBL_OFF + 512);
    __syncthreads();
    Params p; p.tbl = (LAS const unsigned*)(lds + TBL_OFF);
#ifndef PROBE
#define PROBE 0
#endif
    for (int step2 = 0; step2 < 2 * (NLAYER * 13 + 1); ++step2) {
        const int step = step2 >> 1, rep = step2 & 1;
        const int l = step / 13, st = step % 13;
        {
            const bool isg = (st == 1 || st == 2 || st == 4 || st == 9 || st == 11 || st == 12), issc = (st == 6 || st == 8), isother = (st == 0 || st == 3 || st == 5 || st == 10);
            bool dorep = false;
            if ((PROBE & 1) && isg) dorep = true;
            if ((PROBE & 2) && issc) dorep = true;
            if ((PROBE & 4) && isother) dorep = true;
            if ((PROBE & 16) && st == 6) dorep = true;
            if ((PROBE & 32) && st == 8) dorep = true;
            if ((PROBE & 64) && st == 0) dorep = true;
            if ((PROBE & 128) && (st == 3 || st == 10)) dorep = true;
            if ((PROBE & 256) && st == 5) dorep = true;
            if ((PROBE & 512) && st == 7) dorep = true;
            if (step == NLAYER * 13) dorep = false;
            if (rep == 1 && !dorep) { if (PROBE & 8) { if (step != NLAYER * 13) xcd_barrier(xbar); } continue; }
        }
        const float rscale = (rep == 1) ? 0.0f : 1.0f;
        int tid = threadIdx.x; asm volatile("" : "+v"(tid));
        const int lane = tid & 63, wave = __builtin_amdgcn_readfirstlane(tid >> 6), gw = blockIdx.x * 8 + wave;
        unsigned char* ws = p.ws();
        if (step == NLAYER * 13) { if (rep == 0) phase_final_norm((const float*)(ws + WS_X), p.in(33), p.out(), gw, ngw, lane); continue; }
        if (st == 0) phase_convert(p, l, lds, gw, ngw, wave, lane);
        if (st == 0 || st == 3 || st == 10) {
            const float* src = (step == 0) ? p.in(0) : (const float*)(ws + WS_X);
            const float* gain = p.in(st == 0 ? 1 : (st == 3 ? 5 : 29)) + l * D;
            phase_norm(src, gain, (bf16_t*)(ws + WS_H), gw, ngw, lane);
        } else if (st == 1 || st == 11) {
            pg8::Gemm g{(const bf16_t*)(ws + WS_H), (const bf16_t*)(ws + (st == 1 ? WS_WUP1 : WS_WUP2)), T, 2 * FF, D};
            pg8::StaticOrder S; S.init(T, 2 * FF, G, (int)blockIdx.x);
            EpiSwiglu E{(bf16_t*)(ws + WS_ACT)};
            pg8::gemm_phase<EpiSwiglu, pg8::StaticOrder>(lds, g, S, E);
        } else if (st == 2 || st == 9 || st == 12) {
            const int K = (st == 9) ? D : FF;
            pg8::Gemm g{(const bf16_t*)(ws + (st == 9 ? WS_H : WS_ACT)), (const bf16_t*)(ws + (st == 2 ? WS_WDN1 : (st == 9 ? WS_WOUT : WS_WDN2))), T, D, K};
            pg8::StaticOrder S; S.init(T, D, G, (int)blockIdx.x);
            EpiResid E{(float*)(ws + WS_X), (step == 2 && rep == 0) ? p.in(0) : (const float*)(ws + WS_X), (st == 9 ? 1.0f : 0.5f) * rscale};
            pg8::gemm_phase<EpiResid, pg8::StaticOrder>(lds, g, S, E);
        } else if (st == 4) {
            pg8::Gemm g{(const bf16_t*)(ws + WS_H), (const bf16_t*)(ws + WS_WIN), T, NINP, D};
            pg8::StaticOrder S; S.init(T, NINP, G, (int)blockIdx.x);
            EpiProj E{(bf16_t*)(ws + WS_PRW), (bf16_t*)(ws + WS_PHG), (bf16_t*)(ws + WS_PGL)};
            pg8::gemm_phase<EpiProj, pg8::StaticOrder>(lds, g, S, E);
        } else if (st == 5) {
            phase_rwprep(p, l, lds, tid, lane, wave);
        } else if (st == 6 || st == 8) {
            if (st == 6) phase_scan<0>(p, l, lds, tid, lane, wave); else phase_scan<1>(p, l, lds, tid, lane, wave);
        } else if (st == 7) {
            phase_combine(p, lds, tid, lane, wave, rep == 1);
        }
        if (step2 == 0) { grid.sync(); xbar = xcd_barrier_post((unsigned*)(p.ws() + WS_BAR), (volatile LAS unsigned*)(lds + TBL_OFF + 512)); } else xcd_barrier(xbar);
    }
}

extern "C" void kernel_launch(void* const* d_in, const int* in_sizes, int n_in, void* d_out, int out_size, void* d_ws, size_t ws_size, hipStream_t stream) {
    static int grid = 0;
    if (grid == 0) {
        if (n_in != 34 || out_size != T * D || ws_size < WS_END) { fprintf(stderr, "kernel_launch: unexpected shapes (n_in %d, out %d, ws %zu, need %zu)\n", n_in, out_size, ws_size, (size_t)WS_END); grid = -1; return; }
        int dev = 0, cus = 0, per_cu = 0;
        if (hipGetDevice(&dev) != hipSuccess || hipDeviceGetAttribute(&cus, hipDeviceAttributeMultiprocessorCount, dev) != hipSuccess) { grid = -1; return; }
        if (hipFuncSetAttribute((const void*)mega_fwd, hipFuncAttributeMaxDynamicSharedMemorySize, LDS_BYTES) != hipSuccess) { fprintf(stderr, "kernel_launch: hipFuncSetAttribute failed\n"); grid = -1; return; }
        if (hipOccupancyMaxActiveBlocksPerMultiprocessor(&per_cu, (const void*)mega_fwd, 512, LDS_BYTES) != hipSuccess || per_cu < 1) { fprintf(stderr, "kernel_launch: occupancy query says %d\n", per_cu); per_cu = 1; }
        (void)hipGetLastError();
        grid = cus;
    }
    if (grid < 0) return;
    KArgs a{};
    for (int i = 0; i < 34; ++i) a.in[i] = (const float*)d_in[i];
    a.out = (float*)d_out; a.ws = (unsigned char*)d_ws;
    void* args[] = {&a};
    hipError_t e = hipLaunchCooperativeKernel((const void*)mega_fwd, dim3(grid), dim3(512), args, LDS_BYTES, stream);
    if (e != hipSuccess) fprintf(stderr, "cooperative launch failed: %s (grid %d)\n", hipGetErrorString(e), grid);
}
```

```cpp
#include <hip/hip_runtime.h>
#include <hip/hip_cooperative_groups.h>
#include <cstdio>
#include <cstdint>
namespace cg = cooperative_groups;

constexpr int T = 16384, D = 1024, FF = 2816, NLAYER = 4;
constexpr int RWW = 384;
constexpr int PRW = 1536, PHG = 1536, PGL = 1280;
constexpr int NIN = 4112, NINP = 4352;
constexpr int SEG = 128, NSEG = T / SEG;
constexpr int TS = 16;

constexpr size_t MiB = 1024 * 1024;
constexpr size_t WS_X     = 0;
constexpr size_t WS_WUP1  = WS_X + (size_t)T * D * 4;
constexpr size_t WS_WDN1  = WS_WUP1 + (size_t)2 * FF * D * 2;
constexpr size_t WS_WUP2  = WS_WDN1 + (size_t)FF * D * 2;
constexpr size_t WS_WDN2  = WS_WUP2 + (size_t)2 * FF * D * 2;
constexpr size_t WS_WIN   = WS_WDN2 + (size_t)FF * D * 2;
constexpr size_t WS_WOUT  = WS_WIN + (size_t)NINP * D * 2;
constexpr size_t WS_VF    = WS_WOUT + (size_t)D * D * 2;
constexpr size_t WS_H     = WS_VF + (size_t)T * RWW * 2;
constexpr size_t WS_ACT   = WS_H + (size_t)T * D * 2;
constexpr size_t WS_PHG   = WS_ACT;
constexpr size_t WS_PGL   = WS_PHG + (size_t)T * PHG * 2;
constexpr size_t WS_PRW   = WS_ACT + (size_t)T * FF * 2;
constexpr size_t WS_RWL   = WS_PRW;
constexpr size_t WS_RWP   = WS_RWL + (size_t)NSEG * 6 * 4096 * 4;
constexpr size_t WS_HGL   = WS_RWP + (size_t)NSEG * 6 * 4096 * 4;
constexpr size_t WS_RWOPS = WS_PRW + (size_t)T * PRW * 2;
constexpr size_t WS_R     = WS_RWOPS;
constexpr size_t WS_K     = WS_R + (size_t)T * RWW * 2;
constexpr size_t WS_V     = WS_K + (size_t)T * RWW * 2;
constexpr size_t WS_BE    = WS_V + (size_t)T * RWW * 2;
constexpr size_t WS_AL    = WS_BE + (size_t)T * RWW * 2;
constexpr size_t WS_G     = WS_AL + (size_t)T * RWW * 2;
constexpr size_t WS_W     = WS_G + (size_t)T * RWW * 2;
constexpr size_t WS_RK    = WS_W + (size_t)T * RWW * 4;
constexpr size_t WS_GLL   = WS_RK + (size_t)T * 8 * 4;
constexpr size_t WS_HGD   = WS_GLL + (size_t)NSEG * 4 * 4608 * 4;
constexpr size_t WS_GLD   = WS_HGD + (size_t)NSEG * 4 * 128 * 4;
constexpr size_t WS_LW    = WS_GLD + (size_t)NSEG * 4 * 48 * 4;
constexpr size_t WS_LA    = WS_LW + 384 * 64 * 2;
constexpr size_t WS_LG    = WS_LA + 384 * 64 * 2;
constexpr size_t WS_LV    = WS_LG + 384 * 128 * 2;
constexpr size_t WS_BAR   = WS_LV + 384 * 32 * 2;
constexpr size_t WS_END   = WS_BAR + 16384;
static_assert(WS_HGL + (size_t)NSEG * 4 * 8192 * 4 <= WS_RWOPS, "segment states must fit in the projRW region");
static_assert(WS_PGL + (size_t)T * PGL * 2 <= WS_PRW, "projHG + projGL must fit in the act region");
static_assert(WS_END <= (size_t)430438272, "workspace");

#define LAS __attribute__((address_space(3)))
constexpr int LDS_BYTES = 147456;

namespace pg8 {
#define PG8_LAS __attribute__((address_space(3)))
typedef unsigned short bf16_t;
typedef short bf16x8 __attribute__((ext_vector_type(8)));
typedef float f32x4 __attribute__((ext_vector_type(4)));
typedef unsigned u32x4 __attribute__((ext_vector_type(4)));
constexpr int BM = 256, BK = 64, HALF = 128, HTB = HALF * BK * 2  , STAGE_BYTES = 8 * HTB, NXCD = 8, WGM = 8;

__host__ __device__ __forceinline__ int lds_byte(int r, int c) { const int st = (r >> 4) * 2 + (c >> 5), rr = r & 15, cc = c & 31, ob = rr * 64 + cc * 2; return st * 1024 + (ob ^ (((ob >> 9) & 1) << 5)); }
__host__ __device__ __forceinline__ void stage_rc(int b, int& R, int& C) { const int st = b / 1024, sb = b % 1024, swz = sb ^ (((sb >> 9) & 1) << 5); R = (st >> 1) * 16 + swz / 64; C = (st & 1) * 32 + (swz % 64) / 2; }
__host__ __device__ __forceinline__ int perm32(int rho) { const int n = rho >> 4, i = rho & 15; return 8 * (i >> 2) + 4 * n + (i & 3); }

struct Unit { int pm, pn; };
struct Gemm { const bf16_t* A; const bf16_t* Bt; int M, N, K; };

struct StaticOrder {
    int nM, nN, nwg, G, c;
    __host__ __device__ void init(int M, int N, int G_, int c_) { nM = M / BM; nN = N / BM; nwg = nM * nN; G = G_; c = c_; }
    __host__ __device__ bool next(int i, Unit& u) const {
        const long L = (long)i * G + c; if (L >= nwg) return false;
        int wgid = (int)L; { const int q = nwg / NXCD, r = nwg % NXCD, xcd = wgid % NXCD, off = wgid / NXCD; wgid = (xcd < r ? xcd * (q + 1) : r * (q + 1) + (xcd - r) * q) + off; }
        const int nig = WGM * nN, gid = wgid / nig, fm = gid * WGM, gsz = (nM - fm) < WGM ? (nM - fm) : WGM;
        u.pm = fm + ((wgid % nig) % gsz); u.pn = (wgid % nig) / gsz; return true;
    }
    __device__ __forceinline__ void a_ready(const Unit&) const {}
    __device__ __forceinline__ void done(const Unit&) const {}
};
__device__ __forceinline__ unsigned cvt_pk_bf16(float lo, float hi) { unsigned r; asm volatile("v_cvt_pk_bf16_f32 %0, %1, %2" : "=v"(r) : "v"(lo), "v"(hi)); return r; }
template <class Epi, class Sched>
__device__ __forceinline__ void gemm_phase(PG8_LAS unsigned char* lds, const Gemm g, const Sched& S, const Epi& E) {
    int tid_o = threadIdx.x; asm volatile("" : "+v"(tid_o)); const int tid = tid_o, wid = __builtin_amdgcn_readfirstlane(tid >> 6), lane = tid & 63, wr = wid >> 2, wc = wid & 3, fr = lane & 15, fq = lane >> 4;
    const int K = g.K, nt = K / BK;
    unsigned voffA[2], voffB[2];
#pragma unroll
    for (int i = 0; i < 2; ++i) { int R, C; stage_rc(tid * 16 + i * 8192, R, C); const int Rb = Epi::PERM ? ((R & ~31) + perm32(R & 31)) : R;
        voffA[i] = (unsigned)(R * K + C) * 2u; voffB[i] = (unsigned)(Rb * K + C) * 2u; }
    const size_t kstep = (size_t)(BK * 2);
    const size_t hstep = (size_t)HALF * K * 2;
    const size_t tstep = 2 * hstep;
    const unsigned ldsw = (unsigned)wid * 1024u;
    const int aoff = lds_byte(wr * 64 + fr, fq * 8), boff = lds_byte(wc * 32 + fr, fq * 8);
#define PG8_SA(b, h) (((b) * 2 + (h)) * HTB)
#define PG8_SB(b, h) ((4 + (b) * 2 + (h)) * HTB)
#define PG8_STAGE(bufoff, gbase, voff) do { _Pragma("unroll") for (int _i = 0; _i < 2; ++_i) \
        __builtin_amdgcn_global_load_lds((const unsigned*)((const char*)(gbase) + (voff)[_i]), (PG8_LAS unsigned*)(lds + (bufoff) + ldsw + _i * 8192), 16, 0, 0); } while (0)
#define PG8_LDA(dst, b, h) do { _Pragma("unroll") for (int m = 0; m < 4; ++m) _Pragma("unroll") for (int k = 0; k < 2; ++k) dst[m][k] = *(const PG8_LAS bf16x8*)(lds + PG8_SA(b, h) + aoff + m * 2048 + k * 1024); } while (0)
#define PG8_LDB(dst, b, h) do { _Pragma("unroll") for (int n = 0; n < 2; ++n) _Pragma("unroll") for (int k = 0; k < 2; ++k) dst[n][k] = *(const PG8_LAS bf16x8*)(lds + PG8_SB(b, h) + boff + n * 2048 + k * 1024); } while (0)
#define PG8_MMA(ai, bj, At, Bt) do { __builtin_amdgcn_s_setprio(1); _Pragma("unroll") for (int m = 0; m < 4; ++m) _Pragma("unroll") for (int n = 0; n < 2; ++n) _Pragma("unroll") for (int k = 0; k < 2; ++k) \
        acc[ai][bj][m][n] = __builtin_amdgcn_mfma_f32_16x16x32_bf16(Bt[n][k], At[m][k], acc[ai][bj][m][n], 0, 0, 0); __builtin_amdgcn_s_setprio(0); } while (0)
#define PG8_WAIT_V(n) asm volatile("s_waitcnt vmcnt(" #n ")" ::: "memory")
#define PG8_WAIT_L(n) asm volatile("s_waitcnt lgkmcnt(" #n ")" ::: "memory")
#define PG8_BAR __builtin_amdgcn_s_barrier()
#define PG8_SCHED __builtin_amdgcn_sched_barrier(0)
    Unit cur, nxt; int ui = 0;
    if (!S.next(0, cur)) return;
    f32x4 acc[2][2][4][2];
#pragma unroll
    for (int a = 0; a < 2; ++a)
#pragma unroll
        for (int b = 0; b < 2; ++b)
#pragma unroll
            for (int m = 0; m < 4; ++m)
#pragma unroll
                for (int n = 0; n < 2; ++n) acc[a][b][m][n] = (f32x4){0.f, 0.f, 0.f, 0.f};
    bf16x8 At[4][2], B0[2][2], B1[2][2];
    const char* cA = (const char*)g.A + (size_t)cur.pm * tstep; const char* cB = (const char*)g.Bt + (size_t)cur.pn * tstep;
    S.a_ready(cur);
    PG8_STAGE(PG8_SB(0, 0), cB, voffB); PG8_STAGE(PG8_SA(0, 0), cA, voffA); PG8_STAGE(PG8_SB(0, 1), cB + hstep, voffB); PG8_STAGE(PG8_SA(0, 1), cA + hstep, voffA);
    if (wr == 1) PG8_BAR;
    PG8_WAIT_V(4); PG8_BAR;
    PG8_STAGE(PG8_SB(1, 0), cB + kstep, voffB); PG8_STAGE(PG8_SA(1, 0), cA + kstep, voffA); PG8_STAGE(PG8_SB(1, 1), cB + hstep + kstep, voffB);
    PG8_WAIT_V(6); PG8_BAR;
    for (;;) {
        const bool has_next = S.next(ui + 1, nxt);
        const char* nA = has_next ? (const char*)g.A + (size_t)nxt.pm * tstep : cA; const char* nB = has_next ? (const char*)g.Bt + (size_t)nxt.pn * tstep : cB;
        for (int t = 0; t < nt; t += 2) {
            const bool last = (t == nt - 2);
            const char* a1 = cA + (size_t)(t + 1) * kstep;
            const char* a2 = last ? nA : cA + (size_t)(t + 2) * kstep; const char* b2 = last ? nB : cB + (size_t)(t + 2) * kstep;
            const char* a3 = a2 + kstep; const char* b3 = b2 + kstep;
            if (last && has_next) S.a_ready(nxt);
            PG8_LDB(B0, 0, 0); PG8_SCHED; PG8_LDA(At, 0, 0); PG8_STAGE(PG8_SA(1, 1), a1 + hstep, voffA);
            PG8_WAIT_L(8); PG8_BAR; PG8_WAIT_L(0); PG8_MMA(0, 0, At, B0); PG8_BAR; PG8_SCHED;
            PG8_LDB(B1, 0, 1); PG8_STAGE(PG8_SB(0, 0), b2, voffB);
            PG8_BAR; PG8_WAIT_L(0); PG8_MMA(0, 1, At, B1); PG8_BAR;
            PG8_LDA(At, 0, 1); PG8_STAGE(PG8_SA(0, 0), a2, voffA);
            PG8_BAR; PG8_WAIT_L(0); PG8_MMA(1, 0, At, B0); PG8_BAR; PG8_SCHED;
            PG8_STAGE(PG8_SB(0, 1), b2 + hstep, voffB);
            PG8_WAIT_V(6); PG8_BAR; PG8_MMA(1, 1, At, B1); PG8_BAR;
            PG8_LDB(B0, 1, 0); PG8_SCHED; PG8_LDA(At, 1, 0); PG8_STAGE(PG8_SA(0, 1), a2 + hstep, voffA);
            PG8_WAIT_L(8); PG8_BAR; PG8_WAIT_L(0); PG8_MMA(0, 0, At, B0); PG8_BAR; PG8_SCHED;
            PG8_LDB(B1, 1, 1); PG8_STAGE(PG8_SB(1, 0), b3, voffB);
            PG8_BAR; PG8_WAIT_L(0); PG8_MMA(0, 1, At, B1); PG8_BAR;
            PG8_LDA(At, 1, 1); PG8_STAGE(PG8_SA(1, 0), a3, voffA);
            PG8_BAR; PG8_WAIT_L(0); PG8_MMA(1, 0, At, B0); PG8_BAR; PG8_SCHED;
            PG8_STAGE(PG8_SB(1, 1), b3 + hstep, voffB);
            PG8_WAIT_V(6); PG8_BAR; PG8_MMA(1, 1, At, B1); PG8_BAR;
        }
        if constexpr (!Epi::AFTER_DRAIN) { E(acc, cur, wr, wc, fr, fq); S.done(cur); }
        if (!has_next) break;
#pragma unroll
        for (int a = 0; a < 2; ++a)
#pragma unroll
            for (int b = 0; b < 2; ++b)
#pragma unroll
                for (int m = 0; m < 4; ++m)
#pragma unroll
                    for (int n = 0; n < 2; ++n) acc[a][b][m][n] = (f32x4){0.f, 0.f, 0.f, 0.f};
        cur = nxt; cA = nA; cB = nB; ++ui;
    }
    PG8_WAIT_V(0);
    if (wr == 0) PG8_BAR;
    PG8_BAR;
    if constexpr (Epi::AFTER_DRAIN) { E.fused(acc, cur, wr, wc, fr, fq, lds, wid, lane); S.done(cur); }
#undef PG8_SA
#undef PG8_SB
#undef PG8_STAGE
#undef PG8_LDA
#undef PG8_LDB
#undef PG8_MMA
#undef PG8_WAIT_V
#undef PG8_WAIT_L
#undef PG8_BAR
#undef PG8_SCHED
}
}


typedef pg8::bf16_t bf16_t;
typedef pg8::f32x4 f32x4;
typedef pg8::u32x4 u32x4;
typedef unsigned u32x2 __attribute__((ext_vector_type(2)));
typedef float f32x2 __attribute__((ext_vector_type(2)));

struct KArgs { const float* in[34]; float* out; unsigned char* ws; };
constexpr int TBL_OFF = 145408;
struct Params {
    LAS const unsigned* tbl;
    __device__ __forceinline__ unsigned long long ld(int i) const {
        const unsigned lo = __builtin_amdgcn_readfirstlane(tbl[2 * i]), hi = __builtin_amdgcn_readfirstlane(tbl[2 * i + 1]);
        return ((unsigned long long)hi << 32) | lo;
    }
    __device__ __forceinline__ const float* in(int i) const { return (const float*)(const __attribute__((address_space(1))) float*)ld(i); }
    __device__ __forceinline__ float* out() const { return (float*)(__attribute__((address_space(1))) float*)ld(34); }
    __device__ __forceinline__ unsigned char* ws() const { return (unsigned char*)(__attribute__((address_space(1))) unsigned char*)ld(35); }
};

__device__ __forceinline__ float bf2f(bf16_t b) { return __uint_as_float(((unsigned)b) << 16); }
__device__ __forceinline__ bf16_t f2bf(float f) { unsigned u = __float_as_uint(f); u += 0x7FFFu + ((u >> 16) & 1u); return (bf16_t)(u >> 16); }
__device__ __forceinline__ unsigned pk2(float lo, float hi) { return pg8::cvt_pk_bf16(lo, hi); }
__device__ __forceinline__ float sigm(float x) { return __builtin_amdgcn_rcpf(1.0f + __expf(-x)); }
__device__ __forceinline__ float silu(float x) { return x * __builtin_amdgcn_rcpf(1.0f + __expf(-x)); }
template <int CTRL> __device__ __forceinline__ float dpp_mov(float v) { return __int_as_float(__builtin_amdgcn_update_dpp(0, __float_as_int(v), CTRL, 0xF, 0xF, true)); }
__device__ __forceinline__ float wave_sum(float v) {
    v += dpp_mov<0xB1>(v); v += dpp_mov<0x4E>(v); v += dpp_mov<0x141>(v); v += dpp_mov<0x140>(v);
    v += __int_as_float(__builtin_amdgcn_update_dpp(0, __float_as_int(v), 0x142, 0xa, 0xf, false));
    v += __int_as_float(__builtin_amdgcn_update_dpp(0, __float_as_int(v), 0x143, 0xc, 0xf, false));
    return __int_as_float(__builtin_amdgcn_readlane(__float_as_int(v), 63));
}
#define LDS_WAIT() asm volatile("s_waitcnt lgkmcnt(0)" ::: "memory")
__device__ __forceinline__ void lds_barrier() { asm volatile("s_waitcnt lgkmcnt(0)" ::: "memory"); __builtin_amdgcn_s_barrier(); asm volatile("" ::: "memory"); }

struct EpiSwiglu {
    static constexpr bool PERM = true, AFTER_DRAIN = false;
    bf16_t* O;
    __device__ __forceinline__ void operator()(const f32x4 (&acc)[2][2][4][2], const pg8::Unit& u, int wr, int wc, int fr, int fq) const {
        const int row0 = u.pm * 256 + wr * 64 + fr, col0 = u.pn * 128 + wc * 32 + 8 * fq;
#pragma unroll
        for (int ai = 0; ai < 2; ++ai)
#pragma unroll
            for (int m = 0; m < 4; ++m) {
                bf16_t* p = O + (size_t)(row0 + ai * 128 + m * 16) * FF + col0;
                const f32x4 g0 = acc[ai][0][m][0], g1 = acc[ai][0][m][1], u0 = acc[ai][1][m][0], u1 = acc[ai][1][m][1];
                u32x4 w;
                w.x = pk2(silu(g0[0]) * u0[0], silu(g0[1]) * u0[1]); w.y = pk2(silu(g0[2]) * u0[2], silu(g0[3]) * u0[3]);
                w.z = pk2(silu(g1[0]) * u1[0], silu(g1[1]) * u1[1]); w.w = pk2(silu(g1[2]) * u1[2], silu(g1[3]) * u1[3]);
                *(u32x4*)p = w;
            }
    }
};
struct EpiResid {
    static constexpr bool PERM = false, AFTER_DRAIN = false;
    float* X; const float* Xs; float scale;
    __device__ __forceinline__ void operator()(const f32x4 (&acc)[2][2][4][2], const pg8::Unit& u, int wr, int wc, int fr, int fq) const {
        const int row0 = u.pm * 256 + wr * 64 + fr, col0 = u.pn * 256 + wc * 32 + 4 * fq;
#pragma unroll
        for (int ai = 0; ai < 2; ++ai)
#pragma unroll
            for (int m = 0; m < 4; ++m) {
                const size_t ro = (size_t)(row0 + ai * 128 + m * 16) * D + col0;
#pragma unroll
                for (int bj = 0; bj < 2; ++bj)
#pragma unroll
                    for (int n = 0; n < 2; ++n) { const size_t o = ro + bj * 128 + n * 16; *(f32x4*)(X + o) = *(const f32x4*)(Xs + o) + acc[ai][bj][m][n] * scale; }
            }
    }
};
struct EpiProj {
    static constexpr bool PERM = true, AFTER_DRAIN = false;
    bf16_t *PR, *PH, *PG;
    __device__ __forceinline__ void operator()(const f32x4 (&acc)[2][2][4][2], const pg8::Unit& u, int wr, int wc, int fr, int fq) const {
        bf16_t* base; int pitch, colt;
        if (u.pn < 6) { base = PR; pitch = PRW; colt = 256 * u.pn; }
        else if (u.pn < 12) { base = PH; pitch = PHG; colt = 256 * (u.pn - 6); }
        else { base = PG; pitch = PGL; colt = 256 * (u.pn - 12); }
        const int row0 = u.pm * 256 + wr * 64 + fr, col0 = colt + wc * 32 + 8 * fq;
#pragma unroll
        for (int ai = 0; ai < 2; ++ai)
#pragma unroll
            for (int m = 0; m < 4; ++m) {
                bf16_t* rowp = base + (size_t)(row0 + ai * 128 + m * 16) * pitch + col0;
#pragma unroll
                for (int bj = 0; bj < 2; ++bj) {
                    const f32x4 v0 = acc[ai][bj][m][0], v1 = acc[ai][bj][m][1];
                    u32x4 w; w.x = pk2(v0[0], v0[1]); w.y = pk2(v0[2], v0[3]); w.z = pk2(v1[0], v1[1]); w.w = pk2(v1[2], v1[3]);
                    *(u32x4*)(rowp + bj * 128) = w;
                }
            }
    }
};

__device__ __forceinline__ void tr_item(const float* W, int K, int N, bf16_t* WT, int rowbase, int k0, int n0, LAS float* scr, int lane) {
    const int n = n0 + (lane & 31);
    float tv[32];
#pragma unroll
    for (int i = 0; i < 32; ++i) { const int kk = 2 * i + (lane >> 5); tv[i] = 0.f; if (n < N) tv[i] = W[(size_t)(k0 + kk) * N + n]; }
#pragma unroll
    for (int i = 0; i < 32; ++i) { const int kk = 2 * i + (lane >> 5); scr[kk * 33 + (lane & 31)] = tv[i]; }
    LDS_WAIT();
    const int c = lane & 7;
#pragma unroll
    for (int j = 0; j < 4; ++j) {
        const int nn = (lane >> 3) + 8 * j; const LAS float* s = scr + (8 * c) * 33 + nn;
        u32x4 o; o.x = pk2(s[0 * 33], s[1 * 33]); o.y = pk2(s[2 * 33], s[3 * 33]); o.z = pk2(s[4 * 33], s[5 * 33]); o.w = pk2(s[6 * 33], s[7 * 33]);
        *(u32x4*)(WT + (size_t)(rowbase + nn) * K + k0 + 8 * c) = o;
    }
    LDS_WAIT();
}

__device__ __forceinline__ void phase_convert(const Params& p, int l, LAS unsigned char* lds, int gw, int ngw, int wave, int lane) {
    LAS float* scr = (LAS float*)(lds + wave * 8704);
    unsigned char* ws = p.ws();
    constexpr int I_UP = 16 * 88, I_DN = 44 * 32, I_IN = 16 * 129, I_VR = 16, I_OUT = 16 * 32, I_Z = 192;
    constexpr int NIT = 4 * I_UP + 2 * I_DN + I_IN + I_VR + I_OUT + I_Z;
    for (int it = gw; it < NIT; it += ngw) {
        int r = it;
        if (r < 4 * I_UP) {
            const int which = r / I_UP; r -= which * I_UP;
            const int src = (which == 0) ? 2 : (which == 1) ? 3 : (which == 2) ? 30 : 31;
            bf16_t* dst = (bf16_t*)(ws + ((which < 2) ? WS_WUP1 : WS_WUP2));
            const int kb = r / 88, nb = r % 88, n0 = 32 * nb;
            const int rowbase = 256 * (n0 / 128) + (n0 % 128) + ((which & 1) ? 128 : 0);
            tr_item(p.in(src) + (size_t)l * D * FF, D, FF, dst, rowbase, 64 * kb, n0, scr, lane);
            continue;
        }
        r -= 4 * I_UP;
        if (r < 2 * I_DN) {
            const int which = r / I_DN; r -= which * I_DN;
            const int kb = r / 32, nb = r % 32;
            tr_item(p.in(which ? 32 : 4) + (size_t)l * FF * D, FF, D, (bf16_t*)(ws + (which ? WS_WDN2 : WS_WDN1)), 32 * nb, 64 * kb, 32 * nb, scr, lane);
            continue;
        }
        r -= 2 * I_DN;
        if (r < I_IN) {
            const int kb = r / 129, nb = r % 129, n0 = 32 * nb;
            const int rowbase = n0 < 1408 ? n0 : (n0 < 2944 ? 1536 + (n0 - 1408) : 3072 + (n0 - 2944));
            tr_item(p.in(6) + (size_t)l * D * NIN, D, NIN, (bf16_t*)(ws + WS_WIN), rowbase, 64 * kb, n0, scr, lane);
            continue;
        }
        r -= I_IN;
        if (r < I_VR) {
            const int lv = l > 0 ? l - 1 : 0;
            tr_item(p.in(19) + (size_t)lv * D * 32, D, l > 0 ? 32 : 0, (bf16_t*)(ws + WS_WIN), 1408, 64 * r, 0, scr, lane);
            continue;
        }
        r -= I_VR;
        if (r < I_OUT) {
            const int kb = r / 32, nb = r % 32;
            tr_item(p.in(7) + (size_t)l * D * D, D, D, (bf16_t*)(ws + WS_WOUT), 32 * nb, 64 * kb, 32 * nb, scr, lane);
            continue;
        }
        r -= I_OUT;
        {
            const int row = r < 96 ? 1440 + r : 4256 + (r - 96);
            u32x4* q = (u32x4*)((bf16_t*)(ws + WS_WIN) + (size_t)row * D);
            const u32x4 z = {0u, 0u, 0u, 0u};
            q[lane] = z; q[64 + lane] = z;
        }
    }
    {
        bf16_t* LW = (bf16_t*)(ws + WS_LW); bf16_t* LA = (bf16_t*)(ws + WS_LA); bf16_t* LG = (bf16_t*)(ws + WS_LG); bf16_t* LV = (bf16_t*)(ws + WS_LV);
        const float* wu = p.in(10) + (size_t)l * 64 * RWW; const float* au = p.in(12) + (size_t)l * 64 * RWW; const float* gu = p.in(13) + (size_t)l * 128 * RWW;
        const float* vu = p.in(22) + (size_t)(l > 0 ? l - 1 : 0) * 32 * RWW;
        for (int idx = gw * 64 + lane; idx < 110592; idx += ngw * 64) {
            if (idx < 24576) { const int c = idx >> 6, k = idx & 63; LW[idx] = f2bf(wu[k * RWW + c]); }
            else if (idx < 49152) { const int i = idx - 24576, c = i >> 6, k = i & 63; LA[i] = f2bf(au[k * RWW + c]); }
            else if (idx < 98304) { const int i = idx - 49152, c = i >> 7, k = i & 127; LG[i] = f2bf(gu[k * RWW + c]); }
            else { const int i = idx - 98304, c = i >> 5, k = i & 31; LV[i] = (l > 0) ? f2bf(vu[k * RWW + c]) : (bf16_t)0; }
        }
    }
}

__device__ __forceinline__ void phase_norm(const float* x, const float* gain, bf16_t* h, int gw, int ngw, int lane) {
    f32x4 gv[4];
#pragma unroll
    for (int j = 0; j < 4; ++j) gv[j] = *(const f32x4*)(gain + j * 256 + lane * 4);
    for (int row = gw; row < T; row += 2 * ngw) {
        const bool two = row + ngw < T;
        const int row1 = two ? row + ngw : row;
        const f32x4* xr0 = (const f32x4*)(x + (size_t)row * D) + lane; const f32x4* xr1 = (const f32x4*)(x + (size_t)row1 * D) + lane;
        f32x4 v[4], w[4]; float s0 = 0.f, s1 = 0.f;
#pragma unroll
        for (int j = 0; j < 4; ++j) { v[j] = xr0[64 * j]; w[j] = xr1[64 * j]; }
#pragma unroll
        for (int j = 0; j < 4; ++j) { s0 += (v[j].x * v[j].x + v[j].y * v[j].y) + (v[j].z * v[j].z + v[j].w * v[j].w); s1 += (w[j].x * w[j].x + w[j].y * w[j].y) + (w[j].z * w[j].z + w[j].w * w[j].w); }
        const float r0 = rsqrtf(wave_sum(s0) * (1.0f / D) + 1e-5f), r1 = rsqrtf(wave_sum(s1) * (1.0f / D) + 1e-5f);
        unsigned long long* o0 = (unsigned long long*)(h + (size_t)row * D) + lane; unsigned long long* o1 = (unsigned long long*)(h + (size_t)row1 * D) + lane;
#pragma unroll
        for (int j = 0; j < 4; ++j) {
            const f32x4 y = v[j] * r0 * gv[j], z = w[j] * r1 * gv[j];
            o0[64 * j] = (unsigned long long)pk2(y.x, y.y) | ((unsigned long long)pk2(y.z, y.w) << 32);
            o1[64 * j] = (unsigned long long)pk2(z.x, z.y) | ((unsigned long long)pk2(z.z, z.w) << 32);
        }
    }
}
__device__ __forceinline__ void phase_final_norm(const float* x, const float* gain, float* out, int gw, int ngw, int lane) {
    f32x4 gv[4];
#pragma unroll
    for (int j = 0; j < 4; ++j) gv[j] = *(const f32x4*)(gain + j * 256 + lane * 4);
    for (int row = gw; row < T; row += ngw) {
        const f32x4* xr = (const f32x4*)(x + (size_t)row * D) + lane;
        f32x4 v[4]; float s = 0.f;
#pragma unroll
        for (int j = 0; j < 4; ++j) { v[j] = xr[64 * j]; s += (v[j].x * v[j].x + v[j].y * v[j].y) + (v[j].z * v[j].z + v[j].w * v[j].w); }
        const float rstd = rsqrtf(wave_sum(s) * (1.0f / D) + 1e-5f);
        f32x4* o = (f32x4*)(out + (size_t)row * D) + lane;
#pragma unroll
        for (int j = 0; j < 4; ++j) o[64 * j] = v[j] * rstd * gv[j];
    }
}

__device__ __forceinline__ void phase_rwprep(const Params& p, int l, LAS unsigned char* lds, int tid, int lane, int wave) {
    constexpr int APITCH = 296, OUT_OFF = 16384;
    LAS bf16_t* Aimg = (LAS bf16_t*)lds;
    LAS float* outL = (LAS float*)(lds + OUT_OFF);
    unsigned char* ws = p.ws();
    const bf16_t* PR = (const bf16_t*)(ws + WS_PRW);
    bf16_t* Rr = (bf16_t*)(ws + WS_R); bf16_t* Kk = (bf16_t*)(ws + WS_K); bf16_t* Vv = (bf16_t*)(ws + WS_V);
    bf16_t* Be = (bf16_t*)(ws + WS_BE); bf16_t* Al = (bf16_t*)(ws + WS_AL); bf16_t* Gg = (bf16_t*)(ws + WS_G);
    bf16_t* VF = (bf16_t*)(ws + WS_VF);
    float* Ww = (float*)(ws + WS_W); float* RK = (float*)(ws + WS_RK);
    const bf16_t* LW = (const bf16_t*)(ws + WS_LW); const bf16_t* LA = (const bf16_t*)(ws + WS_LA);
    const bf16_t* LG = (const bf16_t*)(ws + WS_LG); const bf16_t* LV = (const bf16_t*)(ws + WS_LV);
    const float* mu = p.in(8) + l * 1408;
    const int lv = l > 0 ? l - 1 : 0;
    const float* vmu = p.in(20) + lv * 32;
    for (int tile = blockIdx.x; tile < T / 16; tile += gridDim.x) {
        const int t0 = tile * 16;
        lds_barrier();
        {
            bf16_t cu_[9], pv_[9]; float mu_[9];
#pragma unroll
            for (int e = 0; e < 9; ++e) {
                const int idx = tid + 512 * e, t = idx / 288, j = idx % 288, tok = t0 + t;
                const int col = j < 256 ? 1152 + j : 1408 + (j - 256);
                const bf16_t* q = PR + (size_t)tok * PRW + col;
                cu_[e] = q[0];
                pv_[e] = tok > 0 ? q[-PRW] : (bf16_t)0;
                mu_[e] = j < 256 ? mu[col] : vmu[j - 256];
            }
#pragma unroll
            for (int e = 0; e < 9; ++e) {
                const int idx = tid + 512 * e, t = idx / 288, j = idx % 288;
                const float cur = bf2f(cu_[e]), prev = bf2f(pv_[e]);
                const float z = cur + (prev - cur) * mu_[e];
                float val = j < 64 ? tanhf(z) : (j < 128 ? z : (j < 256 ? sigm(z) : (l > 0 ? z : 0.f)));
                Aimg[t * APITCH + j] = f2bf(val);
            }
        }
        lds_barrier();
        {
            const int row = lane & 15, q = lane >> 4;
            pg8::bf16x8 af[9];
#pragma unroll
            for (int kc = 0; kc < 9; ++kc) af[kc] = *(const LAS pg8::bf16x8*)(Aimg + row * APITCH + 32 * kc + 8 * q);
#pragma unroll
            for (int ci = 0; ci < 3; ++ci) {
                const int ct = wave + 8 * ci, col = 16 * ct + row;
                f32x4 aw = {0.f, 0.f, 0.f, 0.f}, aa = aw, ag = aw, av = aw;
#pragma unroll
                for (int kc = 0; kc < 2; ++kc) {
                    aw = __builtin_amdgcn_mfma_f32_16x16x32_bf16(af[kc], *(const pg8::bf16x8*)(LW + (size_t)col * 64 + 32 * kc + 8 * q), aw, 0, 0, 0);
                    aa = __builtin_amdgcn_mfma_f32_16x16x32_bf16(af[2 + kc], *(const pg8::bf16x8*)(LA + (size_t)col * 64 + 32 * kc + 8 * q), aa, 0, 0, 0);
                }
#pragma unroll
                for (int kc = 0; kc < 4; ++kc)
                    ag = __builtin_amdgcn_mfma_f32_16x16x32_bf16(af[4 + kc], *(const pg8::bf16x8*)(LG + (size_t)col * 128 + 32 * kc + 8 * q), ag, 0, 0, 0);
                if (l > 0) av = __builtin_amdgcn_mfma_f32_16x16x32_bf16(af[8], *(const pg8::bf16x8*)(LV + (size_t)col * 32 + 8 * q), av, 0, 0, 0);
#pragma unroll
                for (int i = 0; i < 4; ++i) {
                    const int o = (4 * q + i) * RWW + col;
                    outL[0 * 16 * RWW + o] = aw[i]; outL[1 * 16 * RWW + o] = aa[i]; outL[2 * 16 * RWW + o] = ag[i]; outL[3 * 16 * RWW + o] = av[i];
                }
            }
        }
        lds_barrier();
        if (tid < RWW) {
            const int c = tid, h = tid >> 6;
            const float w0c = p.in(9)[l * RWW + c], a0c = p.in(11)[l * RWW + c];
            const float v0c = l > 0 ? p.in(21)[lv * RWW + c] : 0.f;
            const float mur = mu[c], muk = mu[384 + c], muv = mu[768 + c];
            const float kkc = p.in(14)[l * RWW + c], kac = p.in(15)[l * RWW + c], rkc = p.in(16)[l * RWW + c];
            bf16_t rr_[17], kr_[17], vr_[17], vf_[16];
#pragma unroll
            for (int t = 0; t < 17; ++t) {
                const int tok = t0 - 1 + t;
                if (tok >= 0) { const bf16_t* qq = PR + (size_t)tok * PRW + c; rr_[t] = qq[0]; kr_[t] = qq[384]; vr_[t] = qq[768]; }
                else { rr_[t] = 0; kr_[t] = 0; vr_[t] = 0; }
            }
#pragma unroll
            for (int t = 0; t < 16; ++t) vf_[t] = (l > 0) ? VF[(size_t)(t0 + t) * RWW + c] : (bf16_t)0;
#pragma unroll
            for (int t = 0; t < 16; ++t) {
                const int tok = t0 + t;
                const float rc = bf2f(rr_[t + 1]), kc = bf2f(kr_[t + 1]), vc = bf2f(vr_[t + 1]);
                const float rp = bf2f(rr_[t]), kp = bf2f(kr_[t]), vp = bf2f(vr_[t]);
                const float r = rc + (rp - rc) * mur, k = kc + (kp - kc) * muk;
                float v = vc + (vp - vc) * muv;
                const size_t o = (size_t)tok * RWW + c;
                const float lw = w0c + outL[0 * 16 * RWW + t * RWW + c];
                const float a = sigm(a0c + outL[1 * 16 * RWW + t * RWW + c]);
                const float g = outL[2 * 16 * RWW + t * RWW + c];
                if (l == 0) VF[o] = f2bf(v);
                else { const float vf = bf2f(vf_[t]); v = v + (vf - v) * sigm(v0c + outL[3 * 16 * RWW + t * RWW + c]); }
                const float kk = k * kkc;
                const float n2 = wave_sum(kk * kk);
                const float kkn = kk * rsqrtf(fmaxf(n2, 1e-24f));
                const float kmod = k * (1.0f + (a - 1.0f) * kac);
                const float rks = wave_sum(r * kmod * rkc);
                Ww[o] = __expf(-0.60653066f * sigm(lw));
                Gg[o] = f2bf(g);
                Rr[o] = f2bf(r); Kk[o] = f2bf(kmod); Vv[o] = f2bf(v); Be[o] = f2bf(kkn); Al[o] = f2bf(kkn * a);
                if (lane == 0) RK[(size_t)tok * 8 + h] = rks;
            }
        }
    }
}

constexpr int TP = 40;
template <int KQ> __device__ __forceinline__ float kq_sum(float v) {
    v += dpp_mov<0xB1>(v); v += dpp_mov<0x4E>(v); v += dpp_mov<0x141>(v);
    if (KQ == 16) v += dpp_mov<0x140>(v);
    return v;
}

template <int pass>
__device__ __forceinline__ void rw_item(const Params& p, int l, int seg, int h, LAS float* sm, int tid, int lane, int wave) {
    unsigned char* ws = p.ws();
    const bf16_t* Rr = (const bf16_t*)(ws + WS_R); const bf16_t* Kk = (const bf16_t*)(ws + WS_K); const bf16_t* Vv = (const bf16_t*)(ws + WS_V);
    const bf16_t* Be = (const bf16_t*)(ws + WS_BE); const bf16_t* Al = (const bf16_t*)(ws + WS_AL); const bf16_t* Gg = (const bf16_t*)(ws + WS_G);
    const float* Ww = (const float*)(ws + WS_W); const float* RK = (const float*)(ws + WS_RK);
    float* Lm = (float*)(ws + WS_RWL); float* Pm = (float*)(ws + WS_RWP);
    bf16_t* MX = (bf16_t*)(ws + WS_H);
    const int kq = tid & 15, jp = tid >> 4, j0 = 2 * jp, j1 = 2 * jp + 1;
    f32x2 sA[2], sB[2], pA[2], pB[2];
#pragma unroll
    for (int i = 0; i < 2; ++i) {
        sA[i] = (f32x2){0.f, 0.f}; sB[i] = (f32x2){0.f, 0.f};
        pA[i] = (f32x2){(kq * 4 + 2 * i == j0) ? 1.f : 0.f, (kq * 4 + 2 * i + 1 == j0) ? 1.f : 0.f};
        pB[i] = (f32x2){(kq * 4 + 2 * i == j1) ? 1.f : 0.f, (kq * 4 + 2 * i + 1 == j1) ? 1.f : 0.f};
    }
    if (pass == 1 && seg > 0) {
        const float* q = Lm + ((size_t)((seg - 1) * 6 + h) * 64 + j0) * 64 + kq * 4;
        const f32x4 a = *(const f32x4*)q, b = *(const f32x4*)(q + 64);
        sA[0] = a.xy; sA[1] = a.zw; sB[0] = b.xy; sB[1] = b.zw;
    }
    float lnw = 0.f, lnb = 0.f;
    if (pass == 1) { lnw = p.in(17)[l * RWW + h * 64 + lane]; lnb = p.in(18)[l * RWW + h * 64 + lane]; }
    float rw_[2]; bf16_t rk_[2], ra_[2], rb_[2], rv_[2], rq_[2];
    const size_t gbase = (size_t)(seg * SEG) * RWW + h * 64 + (tid & 63);
    const int trow = tid >> 6;
#define RW_LOAD(sb) do { _Pragma("unroll") for (int e = 0; e < 2; ++e) { const size_t g = gbase + (size_t)((sb) * TS + trow + 8 * e) * RWW; \
        rw_[e] = Ww[g]; rk_[e] = Kk[g]; ra_[e] = Al[g]; rb_[e] = Be[g]; rv_[e] = Vv[g]; if (pass == 1) rq_[e] = Rr[g]; } } while (0)
#define RW_STORE(buf) do { _Pragma("unroll") for (int e = 0; e < 2; ++e) { LAS float* b_ = sm + (buf) * 6144 + tid + 512 * e; \
        b_[1024] = rw_[e]; b_[2048] = bf2f(rk_[e]); b_[3072] = bf2f(ra_[e]); b_[4096] = bf2f(rb_[e]); b_[5120] = bf2f(rv_[e]); if (pass == 1) b_[0] = bf2f(rq_[e]); } } while (0)
    lds_barrier();
    RW_LOAD(0); RW_STORE(0); RW_LOAD(1);
    lds_barrier();
    for (int sb = 0; sb < SEG / TS; ++sb) {
        const int cur = sb & 1;
        const LAS float* bf = sm + cur * 6144;
        LAS float* ob = sm + 12288 + cur * 1024;
        float pf_rk[2] = {0.f, 0.f}; bf16_t pf_v[2] = {0, 0}, pf_g[2] = {0, 0};
        if (pass == 1) {
#pragma unroll
            for (int rr = 0; rr < 2; ++rr) { const int tok = seg * SEG + sb * TS + wave + 8 * rr; const size_t g = (size_t)tok * RWW + h * 64 + lane; pf_rk[rr] = RK[(size_t)tok * 8 + h]; pf_v[rr] = Vv[g]; pf_g[rr] = Gg[g]; }
        }
        f32x4 nw4 = *(const LAS f32x4*)(bf + 1024 + kq * 4), nk4 = *(const LAS f32x4*)(bf + 2048 + kq * 4);
        f32x4 na4 = *(const LAS f32x4*)(bf + 3072 + kq * 4), nb4 = *(const LAS f32x4*)(bf + 4096 + kq * 4);
        f32x2 nvv = *(const LAS f32x2*)(bf + 5120 + j0);
        f32x4 nq4 = (pass == 1) ? *(const LAS f32x4*)(bf + kq * 4) : (f32x4){0.f, 0.f, 0.f, 0.f};
#pragma unroll 4
        for (int t = 0; t < TS; ++t) {
            const f32x4 w4 = nw4, k4 = nk4, a4 = na4, b4 = nb4, q4 = nq4; const f32x2 vv = nvv;
            {
                const int tn = (t + 1 < TS) ? t + 1 : t, on = tn * 64 + kq * 4;
                nw4 = *(const LAS f32x4*)(bf + 1024 + on); nk4 = *(const LAS f32x4*)(bf + 2048 + on);
                na4 = *(const LAS f32x4*)(bf + 3072 + on); nb4 = *(const LAS f32x4*)(bf + 4096 + on);
                nvv = *(const LAS f32x2*)(bf + 5120 + tn * 64 + j0);
                if (pass == 1) nq4 = *(const LAS f32x4*)(bf + on);
            }
            const f32x2 vA = {vv.x, vv.x}, vB = {vv.y, vv.y};
            f32x2 ua = b4.xy * sA[0], ub = b4.xy * sB[0];
            ua = b4.zw * sA[1] + ua; ub = b4.zw * sB[1] + ub;
            const float uA = kq_sum<16>(ua.x + ua.y), uB = kq_sum<16>(ub.x + ub.y);
            const f32x2 uA2 = {uA, uA}, uB2 = {uB, uB};
            { const f32x2 t0_ = k4.xy * vA - a4.xy * uA2, t1_ = k4.zw * vA - a4.zw * uA2; sA[0] = w4.xy * sA[0] + t0_; sA[1] = w4.zw * sA[1] + t1_; }
            { const f32x2 t0_ = k4.xy * vB - a4.xy * uB2, t1_ = k4.zw * vB - a4.zw * uB2; sB[0] = w4.xy * sB[0] + t0_; sB[1] = w4.zw * sB[1] + t1_; }
            if (pass == 0) {
                f32x2 qa = b4.xy * pA[0], qb = b4.xy * pB[0];
                qa = b4.zw * pA[1] + qa; qb = b4.zw * pB[1] + qb;
                const float gA = kq_sum<16>(qa.x + qa.y), gB = kq_sum<16>(qb.x + qb.y);
                const f32x2 gA2 = {gA, gA}, gB2 = {gB, gB};
                pA[0] = w4.xy * pA[0] - a4.xy * gA2; pA[1] = w4.zw * pA[1] - a4.zw * gA2;
                pB[0] = w4.xy * pB[0] - a4.xy * gB2; pB[1] = w4.zw * pB[1] - a4.zw * gB2;
            } else {
                f32x2 oa = q4.xy * sA[0], ob2 = q4.xy * sB[0];
                oa = q4.zw * sA[1] + oa; ob2 = q4.zw * sB[1] + ob2;
                const float oA = kq_sum<16>(oa.x + oa.y), oB = kq_sum<16>(ob2.x + ob2.y);
                if (kq == 0) *(LAS f32x2*)(ob + t * 64 + j0) = (f32x2){oA, oB};
            }
        }
        if (sb + 1 < SEG / TS) RW_STORE(cur ^ 1);
        if (sb + 2 < SEG / TS) RW_LOAD(sb + 2);
        lds_barrier();
        if (pass == 1) {
            const int t0 = seg * SEG + sb * TS;
#pragma unroll
            for (int rr = 0; rr < 2; ++rr) {
                const int t = wave + 8 * rr, tok = t0 + t, c = h * 64 + lane;
                const float y = ob[t * 64 + lane];
                const float mean = wave_sum(y) * (1.0f / 64.0f);
                const float d = y - mean;
                const float var = wave_sum(d * d) * (1.0f / 64.0f);
                const float yn = d * rsqrtf(var + 64e-5f);
                const float val = yn * lnw + lnb + pf_rk[rr] * bf2f(pf_v[rr]);
                MX[(size_t)tok * D + c] = f2bf(val * bf2f(pf_g[rr]));
            }
        }
    }
#undef RW_LOAD
#undef RW_STORE
    if (pass == 0) {
        float* ql = Lm + ((size_t)(seg * 6 + h) * 64 + j0) * 64 + kq * 4;
        *(f32x4*)ql = (f32x4){sA[0].x, sA[0].y, sA[1].x, sA[1].y}; *(f32x4*)(ql + 64) = (f32x4){sB[0].x, sB[0].y, sB[1].x, sB[1].y};
        float* qp = Pm + ((size_t)(seg * 6 + h) * 64 + j0) * 64 + kq * 4;
        *(f32x4*)qp = (f32x4){pA[0].x, pA[0].y, pA[1].x, pA[1].y}; *(f32x4*)(qp + 64) = (f32x4){pB[0].x, pB[0].y, pB[1].x, pB[1].y};
    }
}

__device__ __forceinline__ float bf_at(const u32x4& a, const u32x4& b, int i) {
    const unsigned w = (i < 8) ? a[(i >> 1) & 3] : b[(i >> 1) & 3];
    return __uint_as_float((i & 1) ? (w & 0xffff0000u) : (w << 16));
}
#define DG_LOAD(sb) do { const int t0_ = seg * SEG + (sb) * TS; \
        if (HG) { _Pragma("unroll") for (int e = 0; e < EQ; ++e) { const int idx = tid + 512 * e; const bf16_t* row = PH + (size_t)(t0_ + (idx >> 7)) * PHG + h * 128 + (idx & 127); rf[e] = row[512]; if (pass == 1) rq[e] = row[0]; } \
                  _Pragma("unroll") for (int e = 0; e < EV; ++e) { const int idx = tid + 512 * e; rv[e] = PH[(size_t)(t0_ + (idx >> 6)) * PHG + 1024 + h * 64 + (idx & 63)]; } } \
        else { _Pragma("unroll") for (int e = 0; e < EQ; ++e) { const int idx = tid + 512 * e; if (idx < NQK) { const int t = idx / 48, c = idx % 48, tok = t0_ + t; \
                    _Pragma("unroll") for (int jj = 0; jj < 4; ++jj) { const int tt = tok - 3 + jj; bf16_t a = 0, b = 0; if (tt >= 0) { const bf16_t* row = PG + (size_t)tt * PGL + h * 48 + c; a = row[192]; if (pass == 1) b = row[0]; } ck[e][jj] = a; cq[e][jj] = b; } \
                    const u32x4* gp = (const u32x4*)(PG + (size_t)tok * PGL + 768); g0[e] = gp[0]; g1[e] = gp[1]; } } \
               _Pragma("unroll") for (int e = 0; e < EV; ++e) { const int idx = tid + 512 * e; const int t = idx / 96, c = idx % 96, tok = t0_ + t; \
                    _Pragma("unroll") for (int jj = 0; jj < 4; ++jj) { const int tt = tok - 3 + jj; bf16_t a = 0; if (tt >= 0) a = PG[(size_t)tt * PGL + 384 + h * 96 + c]; cv[e][jj] = a; } } } } while (0)
#define DG_STORE(buf) do { LAS float* b_ = sm + (buf) * 7680; \
        if (HG) { _Pragma("unroll") for (int e = 0; e < EQ; ++e) { const int idx = tid + 512 * e; const float f = bf2f(rf[e]); const float lb = sm[L_LB2 + (idx & 127)]; \
                    const float sg = __builtin_amdgcn_rcpf(1.0f + __expf(-f)); b_[2048 + idx] = fmaxf(lb + (1.0f - lb) * sg, 1e-30f); b_[4096 + idx] = (1.0f - lb) * (1.0f - sg); if (pass == 1) b_[idx] = silu(bf2f(rq[e])); } \
                  _Pragma("unroll") for (int e = 0; e < EV; ++e) b_[6144 + tid + 512 * e] = bf2f(rv[e]); } \
        else { _Pragma("unroll") for (int e = 0; e < EQ; ++e) { const int idx = tid + 512 * e; if (idx < NQK) { \
                    const int c_ = idx % 48; float aq = 0.f, ak = 0.f; _Pragma("unroll") for (int jj = 0; jj < 4; ++jj) { ak += sm[L_CW + jj * 192 + 48 + c_] * bf2f(ck[e][jj]); if (pass == 1) aq += sm[L_CW + jj * 192 + c_] * bf2f(cq[e][jj]); } \
                    float x = sm[L_GB + c_]; _Pragma("unroll") for (int i = 0; i < 16; ++i) x += bf_at(g0[e], g1[e], i) * sm[L_GUP + i * 48 + c_]; \
                    const float ls = fminf(x, 0.f) - __logf(1.0f + __expf(-fabsf(x))); \
                    b_[2048 + idx] = __expf(ls * (1.0f / 16.0f)); b_[4096 + idx] = silu(ak); if (pass == 1) b_[idx] = silu(aq) * 0.14433756729740643f; } } \
               _Pragma("unroll") for (int e = 0; e < EV; ++e) { const int c_ = (tid + 512 * e) % 96; float av = 0.f; _Pragma("unroll") for (int jj = 0; jj < 4; ++jj) av += sm[L_CW + jj * 192 + 96 + c_] * bf2f(cv[e][jj]); b_[6144 + tid + 512 * e] = silu(av); } } } while (0)

template <bool HG, int pass>
__device__ __forceinline__ void diag_item(const Params& p, int l, int seg, int h, LAS float* sm, int tid, int lane, int wave) {
    constexpr int K = HG ? 128 : 48, V = HG ? 64 : 96, KQ = HG ? 16 : 8, KPT = K / KQ, NP = KPT / 2;
    constexpr int NQK = TS * K, NV = TS * V, EQ = (NQK + 511) / 512, EV = (NV + 511) / 512;
    constexpr int L_LB2 = 18432;
    unsigned char* ws = p.ws();
    const bf16_t* PH = (const bf16_t*)(ws + WS_PHG); const bf16_t* PG = (const bf16_t*)(ws + WS_PGL);
    float* Lm = (float*)(ws + (HG ? WS_HGL : WS_GLL)); float* Dm = (float*)(ws + (HG ? WS_HGD : WS_GLD));
    bf16_t* MX = (bf16_t*)(ws + WS_H);
    const int kq = tid % KQ, jp = tid / KQ, j0 = 2 * jp;
    const bool active = j0 < V;
    f32x2 sA[NP], sB[NP], dt2[NP];
#pragma unroll
    for (int i = 0; i < NP; ++i) { sA[i] = (f32x2){0.f, 0.f}; sB[i] = (f32x2){0.f, 0.f}; dt2[i] = (f32x2){1.f, 1.f}; }
    if (pass == 1 && seg > 0 && active) {
        const float* q = Lm + ((size_t)((seg - 1) * 4 + h) * V + j0) * K + kq * KPT;
#pragma unroll
        for (int i = 0; i < NP; ++i) { sA[i] = *(const f32x2*)(q + 2 * i); sB[i] = *(const f32x2*)(q + K + 2 * i); }
    }
    float gn1 = 0.f, gn2 = 0.f;
    if (pass == 1) {
        if (HG) gn1 = p.in(24)[l * 256 + h * 64 + lane];
        else { gn1 = p.in(28)[l * 384 + h * 96 + lane]; gn2 = lane < 32 ? p.in(28)[l * 384 + h * 96 + 64 + lane] : 0.f; }
    }
    bf16_t rf[EQ], rq[EQ], rv[EV];
    bf16_t cq[EQ][4], ck[EQ][4], cv[EV][4];
    u32x4 g0[EQ], g1[EQ];
    constexpr int L_GUP = 18560, L_CW = 19328, L_GB = 20096;
    lds_barrier();
    if (HG) {
        if (tid < 128) {
            const float* lg = p.in(23) + h * 128 + tid;
            const float x0 = lg[0], x1 = lg[512], x2 = lg[1024], x3 = lg[1536];
            const float m = fmaxf(fmaxf(x0, x1), fmaxf(x2, x3));
            const float e0 = __expf(x0 - m), e1 = __expf(x1 - m), e2 = __expf(x2 - m), e3 = __expf(x3 - m);
            const float inv = 1.0f / (e0 + e1 + e2 + e3);
            float lb = 0.f;
            if (l >= 1) lb += e1; if (l >= 2) lb += e2; if (l >= 3) lb += e3;
            sm[L_LB2 + tid] = lb * inv;
        }
    } else {
        const float* cw = p.in(25) + (size_t)l * 4 * 768;
        for (int i = tid; i < 768; i += 512) { const int r = i / 48, c = i % 48; sm[L_GUP + i] = p.in(26)[(size_t)l * 16 * 192 + r * 192 + h * 48 + c]; }
        for (int i = tid; i < 768; i += 512) { const int jj = i / 192, c = i % 192; const int ch = c < 48 ? h * 48 + c : (c < 96 ? 192 + h * 48 + (c - 48) : 384 + h * 96 + (c - 96)); sm[L_CW + i] = cw[jj * 768 + ch]; }
        if (tid < 48) sm[L_GB + tid] = p.in(27)[l * 192 + h * 48 + tid];
    }
    DG_LOAD(0);
    lds_barrier();
    DG_STORE(0); DG_LOAD(1);
    lds_barrier();
    for (int sb = 0; sb < SEG / TS; ++sb) {
        const int cur = sb & 1;
        const LAS float* bf = sm + cur * 7680;
        LAS float* ob = sm + 15360 + cur * 1536;
        bf16_t pf_g1[2] = {0, 0}, pf_g2[2] = {0, 0};
        if (pass == 1) {
#pragma unroll
            for (int rr = 0; rr < 2; ++rr) { const int tok = seg * SEG + sb * TS + wave + 8 * rr;
                if (HG) pf_g1[rr] = PH[(size_t)tok * PHG + 1280 + h * 64 + lane];
                else { const bf16_t* row = PG + (size_t)tok * PGL + 784 + h * 96; pf_g1[rr] = row[lane]; pf_g2[rr] = lane < 32 ? row[64 + lane] : (bf16_t)0; } }
        }
        if (active) {
#pragma unroll 4
            for (int t = 0; t < TS; ++t) {
                const int o = t * K + kq * KPT;
                const f32x2 vv = *(const LAS f32x2*)(bf + 6144 + t * V + j0);
                const f32x2 vA = {vv.x, vv.x}, vB = {vv.y, vv.y};
                f32x2 dv[NP];
#pragma unroll
                for (int i = 0; i < NP; ++i) {
                    dv[i] = *(const LAS f32x2*)(bf + 2048 + o + 2 * i);
                    const f32x2 kk = *(const LAS f32x2*)(bf + 4096 + o + 2 * i);
                    sA[i] = dv[i] * sA[i] + kk * vA; sB[i] = dv[i] * sB[i] + kk * vB;
                }
                if (pass == 0) {
                    if (jp == 0) {
#pragma unroll
                        for (int i = 0; i < NP; ++i) dt2[i] = dt2[i] * dv[i];
                    }
                } else {
                    f32x2 oa = {0.f, 0.f}, ob2 = {0.f, 0.f};
#pragma unroll
                    for (int i = 0; i < NP; ++i) { const f32x2 q = *(const LAS f32x2*)(bf + o + 2 * i); oa = q * sA[i] + oa; ob2 = q * sB[i] + ob2; }
                    const float oA = kq_sum<KQ>(oa.x + oa.y), oB = kq_sum<KQ>(ob2.x + ob2.y);
                    if (kq == 0) *(LAS f32x2*)(ob + t * V + j0) = (f32x2){oA, oB};
                }
            }
        }
        if (sb + 1 < SEG / TS) DG_STORE(cur ^ 1);
        if (sb + 2 < SEG / TS) DG_LOAD(sb + 2);
        lds_barrier();
        if (pass == 1) {
            const int t0 = seg * SEG + sb * TS;
#pragma unroll
            for (int rr = 0; rr < 2; ++rr) {
                const int t = wave + 8 * rr, tok = t0 + t;
                if (HG) {
                    const float y = ob[t * 64 + lane];
                    const float ms = wave_sum(y * y) * (1.0f / 64.0f);
                    const float yn = y * rsqrtf(ms + 1e-5f);
                    MX[(size_t)tok * D + 384 + h * 64 + lane] = f2bf(yn * gn1 * silu(bf2f(pf_g1[rr])));
                } else {
                    const float y1 = ob[t * 96 + lane];
                    const float y2 = lane < 32 ? ob[t * 96 + 64 + lane] : 0.f;
                    const float ms = wave_sum(y1 * y1 + y2 * y2) * (1.0f / 96.0f);
                    const float rs = rsqrtf(ms + 1e-5f);
                    bf16_t* mo = MX + (size_t)tok * D + 640 + h * 96;
                    mo[lane] = f2bf(y1 * rs * gn1 * silu(bf2f(pf_g1[rr])));
                    if (lane < 32) mo[64 + lane] = f2bf(y2 * rs * gn2 * silu(bf2f(pf_g2[rr])));
                }
            }
        }
    }
    if (pass == 0 && active) {
        float* q = Lm + ((size_t)(seg * 4 + h) * V + j0) * K + kq * KPT;
#pragma unroll
        for (int i = 0; i < NP; ++i) { *(f32x2*)(q + 2 * i) = sA[i]; *(f32x2*)(q + K + 2 * i) = sB[i]; }
        if (jp == 0) {
            float* qd = Dm + (size_t)(seg * 4 + h) * K + kq * KPT;
#pragma unroll
            for (int i = 0; i < NP; ++i) *(f32x2*)(qd + 2 * i) = dt2[i];
        }
    }
}


template <bool HG>
__device__ __forceinline__ void diag_item_A(const Params& p, int l, int seg, int h, LAS float* sm, int tid, int lane, int wave) {
    constexpr int pass = 0;
    constexpr int K = HG ? 128 : 48, V = HG ? 64 : 96;
    constexpr int NQK = TS * K, NV = TS * V, EQ = (NQK + 511) / 512, EV = (NV + 511) / 512;
    constexpr int L_LB2 = 18432, L_GUP = 18560, L_CW = 19328, L_GB = 20096, L_KT = 20480, L_VT = 23040;
    unsigned char* ws = p.ws();
    const bf16_t* PH = (const bf16_t*)(ws + WS_PHG); const bf16_t* PG = (const bf16_t*)(ws + WS_PGL);
    float* Lm = (float*)(ws + (HG ? WS_HGL : WS_GLL)); float* Dm = (float*)(ws + (HG ? WS_HGD : WS_GLD));
    LAS bf16_t* kT = (LAS bf16_t*)(sm + L_KT); LAS bf16_t* vT = (LAS bf16_t*)(sm + L_VT);
    bf16_t rf[EQ], rq[EQ], rv[EV];
    bf16_t cq[EQ][4], ck[EQ][4], cv[EV][4];
    u32x4 g0[EQ], g1[EQ];
    lds_barrier();
    if (HG) {
        if (tid < 128) {
            const float* lg = p.in(23) + h * 128 + tid;
            const float x0 = lg[0], x1 = lg[512], x2 = lg[1024], x3 = lg[1536];
            const float m = fmaxf(fmaxf(x0, x1), fmaxf(x2, x3));
            const float e0 = __expf(x0 - m), e1 = __expf(x1 - m), e2 = __expf(x2 - m), e3 = __expf(x3 - m);
            const float inv = 1.0f / (e0 + e1 + e2 + e3);
            float lb = 0.f;
            if (l >= 1) lb += e1; if (l >= 2) lb += e2; if (l >= 3) lb += e3;
            sm[L_LB2 + tid] = lb * inv;
        }
    } else {
        const float* cw = p.in(25) + (size_t)l * 4 * 768;
        for (int i = tid; i < 768; i += 512) { const int r = i / 48, c = i % 48; sm[L_GUP + i] = p.in(26)[(size_t)l * 16 * 192 + r * 192 + h * 48 + c]; }
        for (int i = tid; i < 768; i += 512) { const int jj = i / 192, c = i % 192; const int ch = c < 48 ? h * 48 + c : (c < 96 ? 192 + h * 48 + (c - 48) : 384 + h * 96 + (c - 96)); sm[L_CW + i] = cw[jj * 768 + ch]; }
        if (tid < 48) sm[L_GB + tid] = p.in(27)[l * 192 + h * 48 + tid];
    }
    for (int i = tid; i < (L_VT - L_KT) + V * TP / 2; i += 512) ((LAS unsigned*)(sm + L_KT))[i] = 0u;
    float R = 1.0f;
    f32x4 acc[4];
#pragma unroll
    for (int i = 0; i < 4; ++i) acc[i] = (f32x4){0.f, 0.f, 0.f, 0.f};
    const int row = lane & 15, q = lane >> 4;
    DG_LOAD(7);
    lds_barrier();
    DG_STORE(1); DG_LOAD(6);
    lds_barrier();
    for (int sbi = 0; sbi < SEG / TS; ++sbi) {
        const int sb = SEG / TS - 1 - sbi, cur = sb & 1;
        const LAS float* bf = sm + cur * 7680;
        if (tid < K) {
            float dd[TS], kk_[TS];
#pragma unroll
            for (int t = 0; t < TS; ++t) { dd[t] = bf[2048 + t * K + tid]; kk_[t] = bf[4096 + t * K + tid]; }
#pragma unroll
            for (int t = TS - 1; t >= 0; --t) { kT[tid * TP + t] = f2bf(kk_[t] * R); R *= dd[t]; }
        }
        { float vv_[EV];
#pragma unroll
          for (int e = 0; e < EV; ++e) vv_[e] = bf[6144 + tid + 512 * e];
#pragma unroll
          for (int e = 0; e < EV; ++e) { const int idx = tid + 512 * e; vT[(idx % V) * TP + (idx / V)] = f2bf(vv_[e]); } }
        lds_barrier();
        if (HG) {
            const pg8::bf16x8 a = *(const LAS pg8::bf16x8*)(kT + (16 * wave + row) * TP + 8 * q);
#pragma unroll
            for (int n = 0; n < 4; ++n) acc[n] = __builtin_amdgcn_mfma_f32_16x16x32_bf16(a, *(const LAS pg8::bf16x8*)(vT + (16 * n + row) * TP + 8 * q), acc[n], 0, 0, 0);
        } else if (wave < 6) {
            const pg8::bf16x8 b = *(const LAS pg8::bf16x8*)(vT + (16 * wave + row) * TP + 8 * q);
#pragma unroll
            for (int m = 0; m < 3; ++m) acc[m] = __builtin_amdgcn_mfma_f32_16x16x32_bf16(*(const LAS pg8::bf16x8*)(kT + (16 * m + row) * TP + 8 * q), b, acc[m], 0, 0, 0);
        }
        if (sbi + 1 < SEG / TS) DG_STORE(cur ^ 1);
        if (sbi + 2 < SEG / TS) DG_LOAD(sb - 2);
        lds_barrier();
    }
    float* Lb = Lm + (size_t)(seg * 4 + h) * V * K;
    if (HG) {
#pragma unroll
        for (int n = 0; n < 4; ++n) *(f32x4*)(Lb + (size_t)(16 * n + row) * K + 16 * wave + 4 * q) = acc[n];
    } else if (wave < 6) {
#pragma unroll
        for (int m = 0; m < 3; ++m) *(f32x4*)(Lb + (size_t)(16 * wave + row) * K + 16 * m + 4 * q) = acc[m];
    }
    if (tid < K) Dm[(size_t)(seg * 4 + h) * K + tid] = R;
}

__device__ __forceinline__ void hg_item_C(const Params& p, int l, int seg, int h, LAS float* sm, int tid, int lane, int wave) {
    constexpr bool HG = true; constexpr int pass = 1;
    constexpr int K = 128, V = 64;
    constexpr int NQK = TS * K, NV = TS * V, EQ = (NQK + 511) / 512, EV = (NV + 511) / 512;
    constexpr int L_LB2 = 18432, L_GUP = 18560, L_CW = 19328, L_GB = 20096;
    constexpr int L_QG = 20480, L_KT = 21568, L_VT = 24128, L_AM = 25408, L_SB = 25728, L_G15 = 30080, L_PART = 30208;
    constexpr int QP = 136, SP = 136;
    (void)L_GUP; (void)L_CW; (void)L_GB;
    unsigned char* ws = p.ws();
    const bf16_t* PH = (const bf16_t*)(ws + WS_PHG); const bf16_t* PG = (const bf16_t*)(ws + WS_PGL);
    const float* Lm = (const float*)(ws + WS_HGL);
    bf16_t* MX = (bf16_t*)(ws + WS_H);
    LAS bf16_t* qG = (LAS bf16_t*)(sm + L_QG); LAS bf16_t* kT = (LAS bf16_t*)(sm + L_KT); LAS bf16_t* vT = (LAS bf16_t*)(sm + L_VT);
    LAS bf16_t* Am = (LAS bf16_t*)(sm + L_AM); LAS bf16_t* Sb = (LAS bf16_t*)(sm + L_SB);
    LAS float* G15 = sm + L_G15; LAS float* part = sm + L_PART;
    bf16_t rf[EQ], rq[EQ], rv[EV];
    bf16_t cq[EQ][4], ck[EQ][4], cv[EV][4];
    u32x4 g0[EQ], g1[EQ];
    const int row = lane & 15, q = lane >> 4;
    const float gn1 = p.in(24)[l * 256 + h * 64 + lane];
    lds_barrier();
    if (tid < 128) {
        const float* lg = p.in(23) + h * 128 + tid;
        const float x0 = lg[0], x1 = lg[512], x2 = lg[1024], x3 = lg[1536];
        const float m = fmaxf(fmaxf(x0, x1), fmaxf(x2, x3));
        const float e0 = __expf(x0 - m), e1 = __expf(x1 - m), e2 = __expf(x2 - m), e3 = __expf(x3 - m);
        const float inv = 1.0f / (e0 + e1 + e2 + e3);
        float lb = 0.f;
        if (l >= 1) lb += e1; if (l >= 2) lb += e2; if (l >= 3) lb += e3;
        sm[L_LB2 + tid] = lb * inv;
    }
    for (int i = tid; i < (L_SB - L_KT); i += 512) ((LAS unsigned*)(sm + L_KT))[i] = 0u;
    f32x4 S[4];
    {
        const float* Lb = Lm + (size_t)((seg > 0 ? seg - 1 : 0) * 4 + h) * V * K;
#pragma unroll
        for (int n = 0; n < 4; ++n) S[n] = (seg > 0) ? *(const f32x4*)(Lb + (size_t)(16 * n + row) * K + 16 * wave + 4 * q) : (f32x4){0.f, 0.f, 0.f, 0.f};
#pragma unroll
        for (int n = 0; n < 4; ++n) { u32x2 w; w.x = pk2(S[n][0], S[n][1]); w.y = pk2(S[n][2], S[n][3]); *(LAS u32x2*)(Sb + (16 * n + row) * SP + 16 * wave + 4 * q) = w; }
    }
    DG_LOAD(0);
    lds_barrier();
    DG_STORE(0); DG_LOAD(1);
    lds_barrier();
    for (int sb = 0; sb < SEG / TS; ++sb) {
        const int cur = sb & 1;
        const LAS float* bf = sm + cur * 7680;
        LAS float* ob = sm + 15360 + cur * 1536;
        bf16_t pf_g1[2];
#pragma unroll
        for (int rr = 0; rr < 2; ++rr) { const int tok = seg * SEG + sb * TS + wave + 8 * rr; pf_g1[rr] = PH[(size_t)tok * PHG + 1280 + h * 64 + lane]; }
        if (tid < 256) {
            const int j = tid >> 4, sl = tid & 15;
            f32x4 z0 = *(const LAS f32x4*)(bf + 4096 + j * K + 8 * sl), z1 = *(const LAS f32x4*)(bf + 4096 + j * K + 8 * sl + 4);
            f32x4 na0 = *(const LAS f32x4*)(bf + j * K + 8 * sl), na1 = *(const LAS f32x4*)(bf + j * K + 8 * sl + 4);
            const int tj1 = (j + 1 < TS) ? j + 1 : j;
            f32x4 nd0 = *(const LAS f32x4*)(bf + 2048 + tj1 * K + 8 * sl), nd1 = *(const LAS f32x4*)(bf + 2048 + tj1 * K + 8 * sl + 4);
            for (int t = j; t < TS; ++t) {
                const f32x4 a0 = na0, a1 = na1, d0 = nd0, d1 = nd1;
                { const int tn = (t + 1 < TS) ? t + 1 : t, tn2 = (t + 2 < TS) ? t + 2 : TS - 1;
                  na0 = *(const LAS f32x4*)(bf + tn * K + 8 * sl); na1 = *(const LAS f32x4*)(bf + tn * K + 8 * sl + 4);
                  nd0 = *(const LAS f32x4*)(bf + 2048 + tn2 * K + 8 * sl); nd1 = *(const LAS f32x4*)(bf + 2048 + tn2 * K + 8 * sl + 4); }
                part[(t * 16 + j) * 20 + sl] = (a0.x * z0.x + a0.y * z0.y) + (a0.z * z0.z + a0.w * z0.w) + (a1.x * z1.x + a1.y * z1.y) + (a1.z * z1.z + a1.w * z1.w);
                z0 = z0 * d0; z1 = z1 * d1;
            }
        } else if (tid < 384) {
            const int c = tid - 256;
            float dd[TS], qq[TS], kk_[TS];
#pragma unroll
            for (int t = 0; t < TS; ++t) { dd[t] = bf[2048 + t * K + c]; qq[t] = bf[t * K + c]; kk_[t] = bf[4096 + t * K + c]; }
            float G = 1.0f;
#pragma unroll
            for (int t = 0; t < TS; ++t) { G *= dd[t]; qG[t * QP + c] = f2bf(qq[t] * G); }
            G15[c] = G;
            float H = 1.0f;
#pragma unroll
            for (int t = TS - 1; t >= 0; --t) { kT[c * TP + t] = f2bf(kk_[t] * H); H *= dd[t]; }
        } else {
            float vv_[8];
#pragma unroll
            for (int e = 0; e < 8; ++e) vv_[e] = bf[6144 + (tid - 384) + 128 * e];
#pragma unroll
            for (int e = 0; e < 8; ++e) { const int idx = (tid - 384) + 128 * e; vT[(idx & 63) * TP + (idx >> 6)] = f2bf(vv_[e]); }
        }
        lds_barrier();
        if (tid < 256) {
            const int t = tid >> 4, j = tid & 15;
            float a = 0.f;
            if (j <= t) {
                const LAS f32x4* pp = (const LAS f32x4*)(part + (t * 16 + j) * 20);
                const f32x4 x0 = pp[0], x1 = pp[1], x2 = pp[2], x3 = pp[3];
                a = ((x0.x + x0.y) + (x0.z + x0.w)) + ((x1.x + x1.y) + (x1.z + x1.w)) + ((x2.x + x2.y) + (x2.z + x2.w)) + ((x3.x + x3.y) + (x3.z + x3.w));
            }
            Am[t * TP + j] = f2bf(a);
        }
        lds_barrier();
        if (wave < 4) {
            f32x4 o = {0.f, 0.f, 0.f, 0.f};
#pragma unroll
            for (int kc = 0; kc < 4; ++kc)
                o = __builtin_amdgcn_mfma_f32_16x16x32_bf16(*(const LAS pg8::bf16x8*)(qG + row * QP + 32 * kc + 8 * q), *(const LAS pg8::bf16x8*)(Sb + (16 * wave + row) * SP + 32 * kc + 8 * q), o, 0, 0, 0);
            o = __builtin_amdgcn_mfma_f32_16x16x32_bf16(*(const LAS pg8::bf16x8*)(Am + row * TP + 8 * q), *(const LAS pg8::bf16x8*)(vT + (16 * wave + row) * TP + 8 * q), o, 0, 0, 0);
#pragma unroll
            for (int i = 0; i < 4; ++i) ob[(4 * q + i) * 64 + 16 * wave + row] = o[i];
        }
        {
            const f32x4 gg = *(const LAS f32x4*)(G15 + 16 * wave + 4 * q);
            const pg8::bf16x8 a = *(const LAS pg8::bf16x8*)(kT + (16 * wave + row) * TP + 8 * q);
#pragma unroll
            for (int n = 0; n < 4; ++n) S[n] = __builtin_amdgcn_mfma_f32_16x16x32_bf16(a, *(const LAS pg8::bf16x8*)(vT + (16 * n + row) * TP + 8 * q), S[n] * gg, 0, 0, 0);
        }
        lds_barrier();
#pragma unroll
        for (int n = 0; n < 4; ++n) { u32x2 w; w.x = pk2(S[n][0], S[n][1]); w.y = pk2(S[n][2], S[n][3]); *(LAS u32x2*)(Sb + (16 * n + row) * SP + 16 * wave + 4 * q) = w; }
#pragma unroll
        for (int rr = 0; rr < 2; ++rr) {
            const int t = wave + 8 * rr, tok = seg * SEG + sb * TS + t;
            const float y = ob[t * 64 + lane];
            const float ms = wave_sum(y * y) * (1.0f / 64.0f);
            const float yn = y * rsqrtf(ms + 1e-5f);
            MX[(size_t)tok * D + 384 + h * 64 + lane] = f2bf(yn * gn1 * silu(bf2f(pf_g1[rr])));
        }
        if (sb + 1 < SEG / TS) DG_STORE(cur ^ 1);
        if (sb + 2 < SEG / TS) DG_LOAD(sb + 2);
        lds_barrier();
    }
}

__device__ __forceinline__ void gl_item_C(const Params& p, int l, int seg, int h, LAS float* sm, int tid, int lane, int wave) {
    constexpr bool HG = false; constexpr int pass = 1;
    constexpr int K = 48, V = 96;
    constexpr int NQK = TS * K, NV = TS * V, EQ = (NQK + 511) / 512, EV = (NV + 511) / 512;
    constexpr int L_LB2 = 18432, L_GUP = 18560, L_CW = 19328, L_GB = 20096;
    constexpr int L_QG = 20480, L_KT = 21056, L_VT = 22016, L_AM = 23936, L_SB = 24256, L_G15 = 27712, L_PART = 27776;
    constexpr int QP = 72, SP = 72;
    (void)L_LB2;
    unsigned char* ws = p.ws();
    const bf16_t* PH = (const bf16_t*)(ws + WS_PHG); const bf16_t* PG = (const bf16_t*)(ws + WS_PGL);
    const float* Lm = (const float*)(ws + WS_GLL);
    bf16_t* MX = (bf16_t*)(ws + WS_H);
    LAS bf16_t* qG = (LAS bf16_t*)(sm + L_QG); LAS bf16_t* kT = (LAS bf16_t*)(sm + L_KT); LAS bf16_t* vT = (LAS bf16_t*)(sm + L_VT);
    LAS bf16_t* Am = (LAS bf16_t*)(sm + L_AM); LAS bf16_t* Sb = (LAS bf16_t*)(sm + L_SB);
    LAS float* G15 = sm + L_G15; LAS float* part = sm + L_PART;
    bf16_t rf[EQ], rq[EQ], rv[EV];
    bf16_t cq[EQ][4], ck[EQ][4], cv[EV][4];
    u32x4 g0[EQ], g1[EQ];
    const int row = lane & 15, q = lane >> 4;
    const float gn1 = p.in(28)[l * 384 + h * 96 + lane], gn2 = lane < 32 ? p.in(28)[l * 384 + h * 96 + 64 + lane] : 0.f;
    lds_barrier();
    {
        const float* cw = p.in(25) + (size_t)l * 4 * 768;
        for (int i = tid; i < 768; i += 512) { const int r = i / 48, c = i % 48; sm[L_GUP + i] = p.in(26)[(size_t)l * 16 * 192 + r * 192 + h * 48 + c]; }
        for (int i = tid; i < 768; i += 512) { const int jj = i / 192, c = i % 192; const int ch = c < 48 ? h * 48 + c : (c < 96 ? 192 + h * 48 + (c - 48) : 384 + h * 96 + (c - 96)); sm[L_CW + i] = cw[jj * 768 + ch]; }
        if (tid < 48) sm[L_GB + tid] = p.in(27)[l * 192 + h * 48 + tid];
    }
    for (int i = tid; i < (L_G15 - L_QG); i += 512) ((LAS unsigned*)(sm + L_QG))[i] = 0u;
    lds_barrier();
    f32x4 S[3];
#pragma unroll
    for (int m = 0; m < 3; ++m) S[m] = (f32x4){0.f, 0.f, 0.f, 0.f};
    if (wave < 6) {
        const float* Lb = Lm + (size_t)((seg > 0 ? seg - 1 : 0) * 4 + h) * V * K;
        if (seg > 0) {
#pragma unroll
            for (int m = 0; m < 3; ++m) S[m] = *(const f32x4*)(Lb + (size_t)(16 * wave + row) * K + 16 * m + 4 * q);
        }
#pragma unroll
        for (int m = 0; m < 3; ++m) { u32x2 w; w.x = pk2(S[m][0], S[m][1]); w.y = pk2(S[m][2], S[m][3]); *(LAS u32x2*)(Sb + (16 * wave + row) * SP + 16 * m + 4 * q) = w; }
    }
    DG_LOAD(0);
    lds_barrier();
    DG_STORE(0); DG_LOAD(1);
    lds_barrier();
    for (int sb = 0; sb < SEG / TS; ++sb) {
        const int cur = sb & 1;
        const LAS float* bf = sm + cur * 7680;
        LAS float* ob = sm + 15360 + cur * 1536;
        bf16_t pf_g1[2], pf_g2[2];
#pragma unroll
        for (int rr = 0; rr < 2; ++rr) { const int tok = seg * SEG + sb * TS + wave + 8 * rr; const bf16_t* rowp = PG + (size_t)tok * PGL + 784 + h * 96; pf_g1[rr] = rowp[lane]; pf_g2[rr] = lane < 32 ? rowp[64 + lane] : (bf16_t)0; }
        if (tid < 256) {
            const int j = tid >> 4, sl = tid & 15;
            float z0 = bf[4096 + j * K + 3 * sl], z1 = bf[4096 + j * K + 3 * sl + 1], z2 = bf[4096 + j * K + 3 * sl + 2];
            float nq0 = bf[j * K + 3 * sl], nq1 = bf[j * K + 3 * sl + 1], nq2 = bf[j * K + 3 * sl + 2];
            const int tj1 = (j + 1 < TS) ? j + 1 : j;
            float nd0 = bf[2048 + tj1 * K + 3 * sl], nd1 = bf[2048 + tj1 * K + 3 * sl + 1], nd2 = bf[2048 + tj1 * K + 3 * sl + 2];
            for (int t = j; t < TS; ++t) {
                const float q0 = nq0, q1 = nq1, q2 = nq2, d0 = nd0, d1 = nd1, d2 = nd2;
                { const int tn = (t + 1 < TS) ? t + 1 : t, tn2 = (t + 2 < TS) ? t + 2 : TS - 1;
                  const LAS float* qp = bf + tn * K + 3 * sl; nq0 = qp[0]; nq1 = qp[1]; nq2 = qp[2];
                  const LAS float* dp = bf + 2048 + tn2 * K + 3 * sl; nd0 = dp[0]; nd1 = dp[1]; nd2 = dp[2]; }
                part[(t * 16 + j) * 20 + sl] = q0 * z0 + q1 * z1 + q2 * z2;
                z0 *= d0; z1 *= d1; z2 *= d2;
            }
        } else if (tid < 256 + K) {
            const int c = tid - 256;
            float dd[TS], qq[TS], kk_[TS];
#pragma unroll
            for (int t = 0; t < TS; ++t) { dd[t] = bf[2048 + t * K + c]; qq[t] = bf[t * K + c]; kk_[t] = bf[4096 + t * K + c]; }
            float G = 1.0f;
#pragma unroll
            for (int t = 0; t < TS; ++t) { G *= dd[t]; qG[t * QP + c] = f2bf(qq[t] * G); }
            G15[c] = G;
            float H = 1.0f;
#pragma unroll
            for (int t = TS - 1; t >= 0; --t) { kT[c * TP + t] = f2bf(kk_[t] * H); H *= dd[t]; }
        } else if (tid >= 384) {
            float vv_[12];
#pragma unroll
            for (int e = 0; e < 12; ++e) vv_[e] = bf[6144 + (tid - 384) + 128 * e];
#pragma unroll
            for (int e = 0; e < 12; ++e) { const int idx = (tid - 384) + 128 * e; vT[(idx % V) * TP + (idx / V)] = f2bf(vv_[e]); }
        }
        lds_barrier();
        if (tid < 256) {
            const int t = tid >> 4, j = tid & 15;
            float a = 0.f;
            if (j <= t) {
                const LAS f32x4* pp = (const LAS f32x4*)(part + (t * 16 + j) * 20);
                const f32x4 x0 = pp[0], x1 = pp[1], x2 = pp[2], x3 = pp[3];
                a = ((x0.x + x0.y) + (x0.z + x0.w)) + ((x1.x + x1.y) + (x1.z + x1.w)) + ((x2.x + x2.y) + (x2.z + x2.w)) + ((x3.x + x3.y) + (x3.z + x3.w));
            }
            Am[t * TP + j] = f2bf(a);
        }
        lds_barrier();
        if (wave < 6) {
            f32x4 o = {0.f, 0.f, 0.f, 0.f};
#pragma unroll
            for (int kc = 0; kc < 2; ++kc)
                o = __builtin_amdgcn_mfma_f32_16x16x32_bf16(*(const LAS pg8::bf16x8*)(qG + row * QP + 32 * kc + 8 * q), *(const LAS pg8::bf16x8*)(Sb + (16 * wave + row) * SP + 32 * kc + 8 * q), o, 0, 0, 0);
            const pg8::bf16x8 vb = *(const LAS pg8::bf16x8*)(vT + (16 * wave + row) * TP + 8 * q);
            o = __builtin_amdgcn_mfma_f32_16x16x32_bf16(*(const LAS pg8::bf16x8*)(Am + row * TP + 8 * q), vb, o, 0, 0, 0);
#pragma unroll
            for (int i = 0; i < 4; ++i) ob[(4 * q + i) * 96 + 16 * wave + row] = o[i];
#pragma unroll
            for (int m = 0; m < 3; ++m) {
                const f32x4 gg = *(const LAS f32x4*)(G15 + 16 * m + 4 * q);
                S[m] = __builtin_amdgcn_mfma_f32_16x16x32_bf16(*(const LAS pg8::bf16x8*)(kT + (16 * m + row) * TP + 8 * q), vb, S[m] * gg, 0, 0, 0);
            }
        }
        lds_barrier();
        if (wave < 6) {
#pragma unroll
            for (int m = 0; m < 3; ++m) { u32x2 w; w.x = pk2(S[m][0], S[m][1]); w.y = pk2(S[m][2], S[m][3]); *(LAS u32x2*)(Sb + (16 * wave + row) * SP + 16 * m + 4 * q) = w; }
        }
#pragma unroll
        for (int rr = 0; rr < 2; ++rr) {
            const int t = wave + 8 * rr, tok = seg * SEG + sb * TS + t;
            const float y1 = ob[t * 96 + lane];
            const float y2 = lane < 32 ? ob[t * 96 + 64 + lane] : 0.f;
            const float ms = wave_sum(y1 * y1 + y2 * y2) * (1.0f / 96.0f);
            const float rs = rsqrtf(ms + 1e-5f);
            bf16_t* mo = MX + (size_t)tok * D + 640 + h * 96;
            mo[lane] = f2bf(y1 * rs * gn1 * silu(bf2f(pf_g1[rr])));
            if (lane < 32) mo[64 + lane] = f2bf(y2 * rs * gn2 * silu(bf2f(pf_g2[rr])));
        }
        if (sb + 1 < SEG / TS) DG_STORE(cur ^ 1);
        if (sb + 2 < SEG / TS) DG_LOAD(sb + 2);
        lds_barrier();
    }
}
#undef DG_LOAD
#undef DG_STORE

template <int pass>
__device__ __forceinline__ void phase_scan(const Params& p, int l, LAS unsigned char* lds, int tid, int lane, int wave) {
    LAS float* sm = (LAS float*)lds;
    constexpr int N_RW = NSEG * 6, N_HG = NSEG * 4, N_GL = NSEG * 4;
    for (int it = blockIdx.x; it < N_RW + N_HG + N_GL; it += gridDim.x) {
        asm volatile("" : "+v"(tid));
        lane = tid & 63; wave = __builtin_amdgcn_readfirstlane(tid >> 6);
        if (it < N_RW) rw_item<pass>(p, l, it / 6, it % 6, sm, tid, lane, wave);
        else if (it < N_RW + N_HG) { if constexpr (pass == 0) diag_item_A<true>(p, l, (it - N_RW) / 4, (it - N_RW) % 4, sm, tid, lane, wave); else hg_item_C(p, l, (it - N_RW) / 4, (it - N_RW) % 4, sm, tid, lane, wave); }
        else { if constexpr (pass == 0) diag_item_A<false>(p, l, (it - N_RW - N_HG) / 4, (it - N_RW - N_HG) % 4, sm, tid, lane, wave); else gl_item_C(p, l, (it - N_RW - N_HG) / 4, (it - N_RW - N_HG) % 4, sm, tid, lane, wave); }
    }
}

__device__ __forceinline__ void phase_combine(const Params& p, LAS unsigned char* lds, int tid, int lane, int wave, bool dummy) {
    unsigned char* ws = p.ws();
    for (int b = blockIdx.x; b < 124; b += gridDim.x) {
        if (b < 24) {
            const int head = b >> 2, nt = b & 3, row = lane & 15, q = lane >> 4;
            float* Lm = (float*)(ws + WS_RWL); const float* Pm = (const float*)(ws + WS_RWP);
            LAS float* buf = (LAS float*)lds;
            LAS float* sbuf = buf + 8192;
            constexpr size_t SS = 6 * 4096;
            const float* pbase = Pm + (size_t)head * 4096 + tid * 8;
            const int wv = wave & 3;
            float* lbase = Lm + ((size_t)head * 64 + 16 * nt + row) * 64 + 16 * wv + 4 * q;
            float* sbase = (dummy ? (float*)(ws + WS_H) : Lm) + ((size_t)head * 64 + 16 * nt + row) * 64 + 16 * wv + 4 * q;
            f32x4 pr[6][2]; f32x4 lq[6];
            lds_barrier();
            { const f32x4* qq = (const f32x4*)pbase; const f32x4 a = qq[0], c = qq[1]; *(LAS f32x4*)(buf + tid * 8) = a; *(LAS f32x4*)(buf + tid * 8 + 4) = c; }
            for (int i = tid; i < 2048; i += 512) sbuf[i] = 0.f;
#pragma unroll
            for (int u = 0; u < 6; ++u) {
                const f32x4* qq = (const f32x4*)(pbase + (size_t)(1 + u) * SS); pr[u][0] = qq[0]; pr[u][1] = qq[1];
                lq[u] = *(const f32x4*)(lbase + (size_t)u * SS);
            }
            lds_barrier();
#define CB_STEP(seg, u, REFILL) do { \
                LAS float* wb = buf + (((seg) + 1) & 1) * 4096 + tid * 8; \
                *(LAS f32x4*)wb = pr[u][0]; *(LAS f32x4*)(wb + 4) = pr[u][1]; \
                f32x4 acc = lq[u]; \
                if (REFILL) { const int sn = ((seg) + 7 < NSEG - 1) ? (seg) + 7 : NSEG - 2; const f32x4* qq = (const f32x4*)(pbase + (size_t)sn * SS); pr[u][0] = qq[0]; pr[u][1] = qq[1]; \
                  const int ln = ((seg) + 6 < NSEG - 1) ? (seg) + 6 : NSEG - 2; lq[u] = *(const f32x4*)(lbase + (size_t)ln * SS); } \
                if (wave < 4) { \
                    const LAS float* pa = buf + ((seg) & 1) * 4096 + q * 64 + 16 * wv + row;        \
                    const LAS float* pb = sbuf + ((seg) & 1) * 1024 + q * 16 + row;                 \
                    float av_[16], bv_[16]; \
                    _Pragma("unroll") for (int s_ = 0; s_ < 16; ++s_) { av_[s_] = pa[s_ * 256]; bv_[s_] = pb[s_ * 64]; } \
                    asm volatile("s_waitcnt lgkmcnt(0)" ::: "memory");        \
                    f32x4 acc2 = {0.f, 0.f, 0.f, 0.f}; \
                    _Pragma("unroll") for (int s_ = 0; s_ < 16; s_ += 2) { acc = __builtin_amdgcn_mfma_f32_16x16x4f32(av_[s_], bv_[s_], acc, 0, 0, 0); acc2 = __builtin_amdgcn_mfma_f32_16x16x4f32(av_[s_ + 1], bv_[s_ + 1], acc2, 0, 0, 0); } \
                    acc = acc + acc2; \
                    *(f32x4*)(sbase + (size_t)(seg) * SS) = acc; \
                    LAS float* sw = sbuf + (((seg) + 1) & 1) * 1024 + (16 * wv + 4 * q) * 16 + row; \
                    sw[0] = acc[0]; sw[16] = acc[1]; sw[32] = acc[2]; sw[48] = acc[3]; \
                } \
                lds_barrier(); } while (0)
            for (int seg0 = 0; seg0 < 126; seg0 += 6) {
                CB_STEP(seg0 + 0, 0, true); CB_STEP(seg0 + 1, 1, true); CB_STEP(seg0 + 2, 2, true);
                CB_STEP(seg0 + 3, 3, true); CB_STEP(seg0 + 4, 4, true); CB_STEP(seg0 + 5, 5, true);
            }
            CB_STEP(126, 0, false);
#undef CB_STEP
            static_assert(NSEG == 128, "combine schedule");
        } else {
            int e = (b - 24) * 512 + tid;
            float* Lm; const float* Dm; size_t lstride, dstride; size_t lo, dof;
            if (e < 4 * 8192) { const int h = e / 8192, rem = e % 8192, c = rem % 128; Lm = (float*)(ws + WS_HGL); Dm = (const float*)(ws + WS_HGD); lstride = 4 * 8192; dstride = 4 * 128; lo = (size_t)h * 8192 + rem; dof = (size_t)h * 128 + c; }
            else { e -= 4 * 8192; const int h = e / 4608, rem = e % 4608, c = rem % 48; Lm = (float*)(ws + WS_GLL); Dm = (const float*)(ws + WS_GLD); lstride = 4 * 4608; dstride = 4 * 48; lo = (size_t)h * 4608 + rem; dof = (size_t)h * 48 + c; }
            float s = 0.f;
            float* Ls = Lm;
            if (dummy) { if (e >= 0 && Lm == (float*)(ws + WS_HGL)) Ls = (float*)(ws + WS_H) + 3145728; else continue; }
            for (int s0 = 0; s0 < NSEG - 1; s0 += 32) {
                float lv[32], dv[32];
#pragma unroll
                for (int i = 0; i < 32; ++i) { const int sg = (s0 + i < NSEG - 1) ? s0 + i : NSEG - 2; lv[i] = Lm[(size_t)sg * lstride + lo]; dv[i] = Dm[(size_t)sg * dstride + dof]; }
#pragma unroll
                for (int i = 0; i < 32; ++i) if (s0 + i < NSEG - 1) { s = dv[i] * s + lv[i]; Ls[(size_t)(s0 + i) * lstride + lo] = s; }
            }
        }
    }
}

#define XB_TMO      128
#define XB_XCNT(j)  (256  + 64 * (j))
#define XB_XSUB(j)  (1280 + 64 * (j))
#define XB_XGEN(j)  (2304 + 64 * (j))
#define XB_TOP      3328
#define XB_TOPGEN   3392
#define XCD_BAR_WORDS 3456
#define XB_SPIN_CAP (1u << 18)

__device__ __forceinline__ unsigned xb_ld(unsigned* p)              { return __hip_atomic_load(p, __ATOMIC_RELAXED, __HIP_MEMORY_SCOPE_AGENT); }
__device__ __forceinline__ unsigned xb_add(unsigned* p, unsigned v) { return __hip_atomic_fetch_add(p, v, __ATOMIC_RELAXED, __HIP_MEMORY_SCOPE_AGENT); }
__device__ __forceinline__ unsigned xb_xcc_id() { return (unsigned)__builtin_amdgcn_s_getreg((3 << 11) | 20) & 0xFu; }
#define XB_SPIN(cond, bar) do { unsigned _sp = 0; while (cond) { __builtin_amdgcn_s_sleep(1); \
    if ((++_sp & 255u) == 0u) { if (xb_ld(&(bar)[XB_TMO])) break; if (_sp > XB_SPIN_CAP) { atomicAdd(&(bar)[XB_TMO], 1u); break; } } } } while (0)

struct XcdBarrier {
    unsigned* bar; unsigned x;
    volatile LAS unsigned* st;
};

__device__ __forceinline__ XcdBarrier xcd_barrier_post(unsigned* bar, volatile LAS unsigned* st) {
    XcdBarrier b; b.bar = bar; b.x = xb_xcc_id(); b.st = st;
    if (threadIdx.x == 0) (void)xb_add(&bar[XB_XCNT(b.x)], 1u);
    return b;
}
__device__ __forceinline__ void xcd_barrier_complete(unsigned* bar, unsigned x, unsigned& nloc, unsigned& nx) {
    const unsigned G = gridDim.x * gridDim.y * gridDim.z;
    unsigned sum, cnt, mine, sp = 0u;
    for (;;) {
        sum = 0u; cnt = 0u; mine = 0u;
#pragma unroll
        for (unsigned j = 0; j < 16; ++j) { const unsigned c = xb_ld(&bar[XB_XCNT(j)]); sum += c; cnt += (c > 0u) ? 1u : 0u; mine = (j == x) ? c : mine; }
        if (sum == G) break;
        __builtin_amdgcn_s_sleep(1);
        if ((++sp & 255u) == 0u) { if (xb_ld(&bar[XB_TMO])) break; if (sp > XB_SPIN_CAP) { atomicAdd(&bar[XB_TMO], 1u); break; } }
    }
    nloc = mine > 0u ? mine : 1u; nx = cnt > 0u ? cnt : 1u;
}

__device__ __forceinline__ void xcd_barrier(const XcdBarrier& b) {
    asm volatile("s_waitcnt vmcnt(0)" ::: "memory");
    __syncthreads();
    if (threadIdx.x == 0) {
        unsigned* bar = b.bar;
        __builtin_amdgcn_s_waitcnt(0);
        unsigned nloc = b.st[0], nx = b.st[1];
        if (nloc == 0u) { xcd_barrier_complete(bar, b.x, nloc, nx); b.st[0] = nloc; b.st[1] = nx; }
        const unsigned old = xb_add(&bar[XB_XSUB(b.x)], 1u);
        const unsigned gen = old / nloc;
        if (old + 1u == (gen + 1u) * nloc) {
            __builtin_amdgcn_fence(__ATOMIC_RELEASE, "agent");
            asm volatile("s_waitcnt vmcnt(0)" ::: "memory");
            const unsigned og = xb_add(&bar[XB_TOP], 1u);
            const unsigned tg = og / nx;
            if (og + 1u == (tg + 1u) * nx) xb_add(&bar[XB_TOPGEN], 1u);
            else XB_SPIN(xb_ld(&bar[XB_TOPGEN]) == tg, bar);
            __builtin_amdgcn_fence(__ATOMIC_ACQUIRE, "agent");
            xb_add(&bar[XB_XGEN(b.x)], 1u);
            asm volatile("s_waitcnt vmcnt(0)" ::: "memory");
        } else {
            XB_SPIN(xb_ld(&bar[XB_XGEN(b.x)]) == gen, bar);
            __builtin_amdgcn_fence(__ATOMIC_ACQUIRE, "agent");
            asm volatile("s_waitcnt vmcnt(0)" ::: "memory");
        }
    }
    __syncthreads();
}

__global__ void __launch_bounds__(512, 2) mega_fwd(KArgs ka) {
    extern __shared__ __attribute__((aligned(16))) unsigned char lds_raw[];
    LAS unsigned char* lds = (LAS unsigned char*)lds_raw;
    cg::grid_group grid = cg::this_grid();
    const int G = gridDim.x, ngw = G * 8;
    if (threadIdx.x == 0) {
        LAS unsigned long long* t = (LAS unsigned long long*)(lds + TBL_OFF);
#pragma unroll
        for (int i = 0; i < 34; ++i) t[i] = (unsigned long long)ka.in[i];
        t[34] = (unsigned long long)ka.out; t[35] = (unsigned long long)ka.ws;
    }
    if (blockIdx.x == 0) { unsigned* bw = (unsigned*)(ka.ws + WS_BAR); for (int i = threadIdx.x; i < XCD_BAR_WORDS; i += 512) bw[i] = 0u; }
    if (threadIdx.x < 4) ((LAS unsigned*)(lds + TBL_OFF + 512))[threadIdx.x] = 0u;
    XcdBarrier xbar; xbar.bar = (unsigned*)(ka.ws + WS_BAR); xbar.x = 0; xbar.st = (volatile LAS unsigned*)(lds + TBL_OFF + 512);
    __syncthreads();
    Params p; p.tbl = (LAS const unsigned*)(lds + TBL_OFF);
#ifndef PROBE
#define PROBE 0
#endif
    for (int step2 = 0; step2 < 2 * (NLAYER * 13 + 1); ++step2) {
        const int step = step2 >> 1, rep = step2 & 1;
        const int l = step / 13, st = step % 13;
        {
            const bool isg = (st == 1 || st == 2 || st == 4 || st == 9 || st == 11 || st == 12), issc = (st == 6 || st == 8), isother = (st == 0 || st == 3 || st == 5 || st == 10);
            bool dorep = false;
            if ((PROBE & 1) && isg) dorep = true;
            if ((PROBE & 2) && issc) dorep = true;
            if ((PROBE & 4) && isother) dorep = true;
            if ((PROBE & 16) && st == 6) dorep = true;
            if ((PROBE & 32) && st == 8) dorep = true;
            if ((PROBE & 64) && st == 0) dorep = true;
            if ((PROBE & 128) && (st == 3 || st == 10)) dorep = true;
            if ((PROBE & 256) && st == 5) dorep = true;
            if ((PROBE & 512) && st == 7) dorep = true;
            if (step == NLAYER * 13) dorep = false;
            if (rep == 1 && !dorep) { if (PROBE & 8) { if (step != NLAYER * 13) xcd_barrier(xbar); } continue; }
        }
        const float rscale = (rep == 1) ? 0.0f : 1.0f;
        int tid = threadIdx.x; asm volatile("" : "+v"(tid));
        const int lane = tid & 63, wave = __builtin_amdgcn_readfirstlane(tid >> 6), gw = blockIdx.x * 8 + wave;
        unsigned char* ws = p.ws();
        if (step == NLAYER * 13) { if (rep == 0) phase_final_norm((const float*)(ws + WS_X), p.in(33), p.out(), gw, ngw, lane); continue; }
        if (st == 0) phase_convert(p, l, lds, gw, ngw, wave, lane);
        if (st == 0 || st == 3 || st == 10) {
            const float* src = (step == 0) ? p.in(0) : (const float*)(ws + WS_X);
            const float* gain = p.in(st == 0 ? 1 : (st == 3 ? 5 : 29)) + l * D;
            phase_norm(src, gain, (bf16_t*)(ws + WS_H), gw, ngw, lane);
        } else if (st == 1 || st == 11) {
            pg8::Gemm g{(const bf16_t*)(ws + WS_H), (const bf16_t*)(ws + (st == 1 ? WS_WUP1 : WS_WUP2)), T, 2 * FF, D};
            pg8::StaticOrder S; S.init(T, 2 * FF, G, (int)blockIdx.x);
            EpiSwiglu E{(bf16_t*)(ws + WS_ACT)};
            pg8::gemm_phase<EpiSwiglu, pg8::StaticOrder>(lds, g, S, E);
        } else if (st == 2 || st == 9 || st == 12) {
            const int K = (st == 9) ? D : FF;
            pg8::Gemm g{(const bf16_t*)(ws + (st == 9 ? WS_H : WS_ACT)), (const bf16_t*)(ws + (st == 2 ? WS_WDN1 : (st == 9 ? WS_WOUT : WS_WDN2))), T, D, K};
            pg8::StaticOrder S; S.init(T, D, G, (int)blockIdx.x);
            EpiResid E{(float*)(ws + WS_X), (step == 2 && rep == 0) ? p.in(0) : (const float*)(ws + WS_X), (st == 9 ? 1.0f : 0.5f) * rscale};
            pg8::gemm_phase<EpiResid, pg8::StaticOrder>(lds, g, S, E);
        } else if (st == 4) {
            pg8::Gemm g{(const bf16_t*)(ws + WS_H), (const bf16_t*)(ws + WS_WIN), T, NINP, D};
            pg8::StaticOrder S; S.init(T, NINP, G, (int)blockIdx.x);
            EpiProj E{(bf16_t*)(ws + WS_PRW), (bf16_t*)(ws + WS_PHG), (bf16_t*)(ws + WS_PGL)};
            pg8::gemm_phase<EpiProj, pg8::StaticOrder>(lds, g, S, E);
        } else if (st == 5) {
            phase_rwprep(p, l, lds, tid, lane, wave);
        } else if (st == 6 || st == 8) {
            if (st == 6) phase_scan<0>(p, l, lds, tid, lane, wave); else phase_scan<1>(p, l, lds, tid, lane, wave);
        } else if (st == 7) {
            phase_combine(p, lds, tid, lane, wave, rep == 1);
        }
        if (step2 == 0) { grid.sync(); xbar = xcd_barrier_post((unsigned*)(p.ws() + WS_BAR), (volatile LAS unsigned*)(lds + TBL_OFF + 512)); } else xcd_barrier(xbar);
    }
}

extern "C" void kernel_launch(void* const* d_in, const int* in_sizes, int n_in, void* d_out, int out_size, void* d_ws, size_t ws_size, hipStream_t stream) {
    static int grid = 0;
    if (grid == 0) {
        if (n_in != 34 || out_size != T * D || ws_size < WS_END) { fprintf(stderr, "kernel_launch: unexpected shapes (n_in %d, out %d, ws %zu, need %zu)\n", n_in, out_size, ws_size, (size_t)WS_END); grid = -1; return; }
        int dev = 0, cus = 0, per_cu = 0;
        if (hipGetDevice(&dev) != hipSuccess || hipDeviceGetAttribute(&cus, hipDeviceAttributeMultiprocessorCount, dev) != hipSuccess) { grid = -1; return; }
        if (hipFuncSetAttribute((const void*)mega_fwd, hipFuncAttributeMaxDynamicSharedMemorySize, LDS_BYTES) != hipSuccess) { fprintf(stderr, "kernel_launch: hipFuncSetAttribute failed\n"); grid = -1; return; }
        if (hipOccupancyMaxActiveBlocksPerMultiprocessor(&per_cu, (const void*)mega_fwd, 512, LDS_BYTES) != hipSuccess || per_cu < 1) { fprintf(stderr, "kernel_launch: occupancy query says %d\n", per_cu); per_cu = 1; }
        (void)hipGetLastError();
        grid = cus;
    }
    if (grid < 0) return;
    KArgs a{};
    for (int i = 0; i < 34; ++i) a.in[i] = (const float*)d_in[i];
    a.out = (float*)d_out; a.ws = (unsigned char*)d_ws;
    void* args[] = {&a};
    hipError_t e = hipLaunchCooperativeKernel((const void*)mega_fwd, dim3(grid), dim3(512), args, LDS_BYTES, stream);
    if (e != hipSuccess) fprintf(stderr, "cooperative launch failed: %s (grid %d)\n", hipGetErrorString(e), grid);
}
```

```cpp
#include <hip/hip_runtime.h>
#include <hip/hip_cooperative_groups.h>
#include <cstdio>
#include <cstdint>
namespace cg = cooperative_groups;

constexpr int T = 16384, D = 1024, FF = 2816, NLAYER = 4;
constexpr int RWW = 384;
constexpr int PRW = 1536, PHG = 1536, PGL = 1280;
constexpr int NIN = 4112, NINP = 4352;
constexpr int SEG = 128, NSEG = T / SEG;
constexpr int TS = 16;

constexpr size_t MiB = 1024 * 1024;
constexpr size_t WS_X     = 0;
constexpr size_t WS_WUP1  = WS_X + (size_t)T * D * 4;
constexpr size_t WS_WDN1  = WS_WUP1 + (size_t)2 * FF * D * 2;
constexpr size_t WS_WUP2  = WS_WDN1 + (size_t)FF * D * 2;
constexpr size_t WS_WDN2  = WS_WUP2 + (size_t)2 * FF * D * 2;
constexpr size_t WS_WIN   = WS_WDN2 + (size_t)FF * D * 2;
constexpr size_t WS_WOUT  = WS_WIN + (size_t)NINP * D * 2;
constexpr size_t WS_VF    = WS_WOUT + (size_t)D * D * 2;
constexpr size_t WS_H     = WS_VF + (size_t)T * RWW * 2;
constexpr size_t WS_ACT   = WS_H + (size_t)T * D * 2;
constexpr size_t WS_PHG   = WS_ACT;
constexpr size_t WS_PGL   = WS_PHG + (size_t)T * PHG * 2;
constexpr size_t WS_PRW   = WS_ACT + (size_t)T * FF * 2;
constexpr size_t WS_RWL   = WS_PRW;
constexpr size_t WS_RWP   = WS_RWL + (size_t)NSEG * 6 * 4096 * 4;
constexpr size_t WS_HGL   = WS_RWP + (size_t)NSEG * 6 * 4096 * 4;
constexpr size_t WS_RWOPS = WS_PRW + (size_t)T * PRW * 2;
constexpr size_t WS_R     = WS_RWOPS;
constexpr size_t WS_K     = WS_R + (size_t)T * RWW * 2;
constexpr size_t WS_V     = WS_K + (size_t)T * RWW * 2;
constexpr size_t WS_BE    = WS_V + (size_t)T * RWW * 2;
constexpr size_t WS_AL    = WS_BE + (size_t)T * RWW * 2;
constexpr size_t WS_G     = WS_AL + (size_t)T * RWW * 2;
constexpr size_t WS_W     = WS_G + (size_t)T * RWW * 2;
constexpr size_t WS_RK    = WS_W + (size_t)T * RWW * 4;
constexpr size_t WS_GLL   = WS_RK + (size_t)T * 8 * 4;
constexpr size_t WS_HGD   = WS_GLL + (size_t)NSEG * 4 * 4608 * 4;
constexpr size_t WS_GLD   = WS_HGD + (size_t)NSEG * 4 * 128 * 4;
constexpr size_t WS_LW    = WS_GLD + (size_t)NSEG * 4 * 48 * 4;
constexpr size_t WS_LA    = WS_LW + 384 * 64 * 2;
constexpr size_t WS_LG    = WS_LA + 384 * 64 * 2;
constexpr size_t WS_LV    = WS_LG + 384 * 128 * 2;
constexpr size_t WS_BAR   = WS_LV + 384 * 32 * 2;
constexpr size_t WS_END   = WS_BAR + 16384;
static_assert(WS_HGL + (size_t)NSEG * 4 * 8192 * 4 <= WS_RWOPS, "segment states must fit in the projRW region");
static_assert(WS_PGL + (size_t)T * PGL * 2 <= WS_PRW, "projHG + projGL must fit in the act region");
static_assert(WS_END <= (size_t)430438272, "workspace");

#define LAS __attribute__((address_space(3)))
constexpr int LDS_BYTES = 147456;

namespace pg8 {
#define PG8_LAS __attribute__((address_space(3)))
typedef unsigned short bf16_t;
typedef short bf16x8 __attribute__((ext_vector_type(8)));
typedef float f32x4 __attribute__((ext_vector_type(4)));
typedef unsigned u32x4 __attribute__((ext_vector_type(4)));
constexpr int BM = 256, BK = 64, HALF = 128, HTB = HALF * BK * 2  , STAGE_BYTES = 8 * HTB, NXCD = 8, WGM = 8;

__host__ __device__ __forceinline__ int lds_byte(int r, int c) { const int st = (r >> 4) * 2 + (c >> 5), rr = r & 15, cc = c & 31, ob = rr * 64 + cc * 2; return st * 1024 + (ob ^ (((ob >> 9) & 1) << 5)); }
__host__ __device__ __forceinline__ void stage_rc(int b, int& R, int& C) { const int st = b / 1024, sb = b % 1024, swz = sb ^ (((sb >> 9) & 1) << 5); R = (st >> 1) * 16 + swz / 64; C = (st & 1) * 32 + (swz % 64) / 2; }
__host__ __device__ __forceinline__ int perm32(int rho) { const int n = rho >> 4, i = rho & 15; return 8 * (i >> 2) + 4 * n + (i & 3); }

struct Unit { int pm, pn; };
struct Gemm { const bf16_t* A; const bf16_t* Bt; int M, N, K; };

struct StaticOrder {
    int nM, nN, nwg, G, c;
    __host__ __device__ void init(int M, int N, int G_, int c_) { nM = M / BM; nN = N / BM; nwg = nM * nN; G = G_; c = c_; }
    __host__ __device__ bool next(int i, Unit& u) const {
        const long L = (long)i * G + c; if (L >= nwg) return false;
        int wgid = (int)L; { const int q = nwg / NXCD, r = nwg % NXCD, xcd = wgid % NXCD, off = wgid / NXCD; wgid = (xcd < r ? xcd * (q + 1) : r * (q + 1) + (xcd - r) * q) + off; }
        const int nig = WGM * nN, gid = wgid / nig, fm = gid * WGM, gsz = (nM - fm) < WGM ? (nM - fm) : WGM;
        u.pm = fm + ((wgid % nig) % gsz); u.pn = (wgid % nig) / gsz; return true;
    }
    __device__ __forceinline__ void a_ready(const Unit&) const {}
    __device__ __forceinline__ void done(const Unit&) const {}
};
__device__ __forceinline__ unsigned cvt_pk_bf16(float lo, float hi) { unsigned r; asm volatile("v_cvt_pk_bf16_f32 %0, %1, %2" : "=v"(r) : "v"(lo), "v"(hi)); return r; }
template <class Epi, class Sched>
__device__ __forceinline__ void gemm_phase(PG8_LAS unsigned char* lds, const Gemm g, const Sched& S, const Epi& E) {
    int tid_o = threadIdx.x; asm volatile("" : "+v"(tid_o)); const int tid = tid_o, wid = __builtin_amdgcn_readfirstlane(tid >> 6), lane = tid & 63, wr = wid >> 2, wc = wid & 3, fr = lane & 15, fq = lane >> 4;
    const int K = g.K, nt = K / BK;
    unsigned voffA[2], voffB[2];
#pragma unroll
    for (int i = 0; i < 2; ++i) { int R, C; stage_rc(tid * 16 + i * 8192, R, C); const int Rb = Epi::PERM ? ((R & ~31) + perm32(R & 31)) : R;
        voffA[i] = (unsigned)(R * K + C) * 2u; voffB[i] = (unsigned)(Rb * K + C) * 2u; }
    const size_t kstep = (size_t)(BK * 2);
    const size_t hstep = (size_t)HALF * K * 2;
    const size_t tstep = 2 * hstep;
    const unsigned ldsw = (unsigned)wid * 1024u;
    const int aoff = lds_byte(wr * 64 + fr, fq * 8), boff = lds_byte(wc * 32 + fr, fq * 8);
#define PG8_SA(b, h) (((b) * 2 + (h)) * HTB)
#define PG8_SB(b, h) ((4 + (b) * 2 + (h)) * HTB)
#define PG8_STAGE(bufoff, gbase, voff) do { _Pragma("unroll") for (int _i = 0; _i < 2; ++_i) \
        __builtin_amdgcn_global_load_lds((const unsigned*)((const char*)(gbase) + (voff)[_i]), (PG8_LAS unsigned*)(lds + (bufoff) + ldsw + _i * 8192), 16, 0, 0); } while (0)
#define PG8_LDA(dst, b, h) do { _Pragma("unroll") for (int m = 0; m < 4; ++m) _Pragma("unroll") for (int k = 0; k < 2; ++k) dst[m][k] = *(const PG8_LAS bf16x8*)(lds + PG8_SA(b, h) + aoff + m * 2048 + k * 1024); } while (0)
#define PG8_LDB(dst, b, h) do { _Pragma("unroll") for (int n = 0; n < 2; ++n) _Pragma("unroll") for (int k = 0; k < 2; ++k) dst[n][k] = *(const PG8_LAS bf16x8*)(lds + PG8_SB(b, h) + boff + n * 2048 + k * 1024); } while (0)
#define PG8_MMA(ai, bj, At, Bt) do { __builtin_amdgcn_s_setprio(1); _Pragma("unroll") for (int m = 0; m < 4; ++m) _Pragma("unroll") for (int n = 0; n < 2; ++n) _Pragma("unroll") for (int k = 0; k < 2; ++k) \
        acc[ai][bj][m][n] = __builtin_amdgcn_mfma_f32_16x16x32_bf16(Bt[n][k], At[m][k], acc[ai][bj][m][n], 0, 0, 0); __builtin_amdgcn_s_setprio(0); } while (0)
#define PG8_WAIT_V(n) asm volatile("s_waitcnt vmcnt(" #n ")" ::: "memory")
#define PG8_WAIT_L(n) asm volatile("s_waitcnt lgkmcnt(" #n ")" ::: "memory")
#define PG8_BAR __builtin_amdgcn_s_barrier()
#define PG8_SCHED __builtin_amdgcn_sched_barrier(0)
    Unit cur, nxt; int ui = 0;
    if (!S.next(0, cur)) return;
    f32x4 acc[2][2][4][2];
#pragma unroll
    for (int a = 0; a < 2; ++a)
#pragma unroll
        for (int b = 0; b < 2; ++b)
#pragma unroll
            for (int m = 0; m < 4; ++m)
#pragma unroll
                for (int n = 0; n < 2; ++n) acc[a][b][m][n] = (f32x4){0.f, 0.f, 0.f, 0.f};
    bf16x8 At[4][2], B0[2][2], B1[2][2];
    const char* cA = (const char*)g.A + (size_t)cur.pm * tstep; const char* cB = (const char*)g.Bt + (size_t)cur.pn * tstep;
    S.a_ready(cur);
    PG8_STAGE(PG8_SB(0, 0), cB, voffB); PG8_STAGE(PG8_SA(0, 0), cA, voffA); PG8_STAGE(PG8_SB(0, 1), cB + hstep, voffB); PG8_STAGE(PG8_SA(0, 1), cA + hstep, voffA);
    if (wr == 1) PG8_BAR;
    PG8_WAIT_V(4); PG8_BAR;
    PG8_STAGE(PG8_SB(1, 0), cB + kstep, voffB); PG8_STAGE(PG8_SA(1, 0), cA + kstep, voffA); PG8_STAGE(PG8_SB(1, 1), cB + hstep + kstep, voffB);
    PG8_WAIT_V(6); PG8_BAR;
    for (;;) {
        const bool has_next = S.next(ui + 1, nxt);
        const char* nA = has_next ? (const char*)g.A + (size_t)nxt.pm * tstep : cA; const char* nB = has_next ? (const char*)g.Bt + (size_t)nxt.pn * tstep : cB;
        for (int t = 0; t < nt; t += 2) {
            const bool last = (t == nt - 2);
            const char* a1 = cA + (size_t)(t + 1) * kstep;
            const char* a2 = last ? nA : cA + (size_t)(t + 2) * kstep; const char* b2 = last ? nB : cB + (size_t)(t + 2) * kstep;
            const char* a3 = a2 + kstep; const char* b3 = b2 + kstep;
            if (last && has_next) S.a_ready(nxt);
            PG8_LDB(B0, 0, 0); PG8_SCHED; PG8_LDA(At, 0, 0); PG8_STAGE(PG8_SA(1, 1), a1 + hstep, voffA);
            PG8_WAIT_L(8); PG8_BAR; PG8_WAIT_L(0); PG8_MMA(0, 0, At, B0); PG8_BAR; PG8_SCHED;
            PG8_LDB(B1, 0, 1); PG8_STAGE(PG8_SB(0, 0), b2, voffB);
            PG8_BAR; PG8_WAIT_L(0); PG8_MMA(0, 1, At, B1); PG8_BAR;
            PG8_LDA(At, 0, 1); PG8_STAGE(PG8_SA(0, 0), a2, voffA);
            PG8_BAR; PG8_WAIT_L(0); PG8_MMA(1, 0, At, B0); PG8_BAR; PG8_SCHED;
            PG8_STAGE(PG8_SB(0, 1), b2 + hstep, voffB);
            PG8_WAIT_V(6); PG8_BAR; PG8_MMA(1, 1, At, B1); PG8_BAR;
            PG8_LDB(B0, 1, 0); PG8_SCHED; PG8_LDA(At, 1, 0); PG8_STAGE(PG8_SA(0, 1), a2 + hstep, voffA);
            PG8_WAIT_L(8); PG8_BAR; PG8_WAIT_L(0); PG8_MMA(0, 0, At, B0); PG8_BAR; PG8_SCHED;
            PG8_LDB(B1, 1, 1); PG8_STAGE(PG8_SB(1, 0), b3, voffB);
            PG8_BAR; PG8_WAIT_L(0); PG8_MMA(0, 1, At, B1); PG8_BAR;
            PG8_LDA(At, 1, 1); PG8_STAGE(PG8_SA(1, 0), a3, voffA);
            PG8_BAR; PG8_WAIT_L(0); PG8_MMA(1, 0, At, B0); PG8_BAR; PG8_SCHED;
            PG8_STAGE(PG8_SB(1, 1), b3 + hstep, voffB);
            PG8_WAIT_V(6); PG8_BAR; PG8_MMA(1, 1, At, B1); PG8_BAR;
        }
        if constexpr (!Epi::AFTER_DRAIN) { E(acc, cur, wr, wc, fr, fq); S.done(cur); }
        if (!has_next) break;
#pragma unroll
        for (int a = 0; a < 2; ++a)
#pragma unroll
            for (int b = 0; b < 2; ++b)
#pragma unroll
                for (int m = 0; m < 4; ++m)
#pragma unroll
                    for (int n = 0; n < 2; ++n) acc[a][b][m][n] = (f32x4){0.f, 0.f, 0.f, 0.f};
        cur = nxt; cA = nA; cB = nB; ++ui;
    }
    PG8_WAIT_V(0);
    if (wr == 0) PG8_BAR;
    PG8_BAR;
    if constexpr (Epi::AFTER_DRAIN) { E.fused(acc, cur, wr, wc, fr, fq, lds, wid, lane); S.done(cur); }
#undef PG8_SA
#undef PG8_SB
#undef PG8_STAGE
#undef PG8_LDA
#undef PG8_LDB
#undef PG8_MMA
#undef PG8_WAIT_V
#undef PG8_WAIT_L
#undef PG8_BAR
#undef PG8_SCHED
}
}


typedef pg8::bf16_t bf16_t;
typedef pg8::f32x4 f32x4;
typedef pg8::u32x4 u32x4;
typedef unsigned u32x2 __attribute__((ext_vector_type(2)));
typedef float f32x2 __attribute__((ext_vector_type(2)));

struct KArgs { const float* in[34]; float* out; unsigned char* ws; };
constexpr int TBL_OFF = 145408;
struct Params {
    LAS const unsigned* tbl;
    __device__ __forceinline__ unsigned long long ld(int i) const {
        const unsigned lo = __builtin_amdgcn_readfirstlane(tbl[2 * i]), hi = __builtin_amdgcn_readfirstlane(tbl[2 * i + 1]);
        return ((unsigned long long)hi << 32) | lo;
    }
    __device__ __forceinline__ const float* in(int i) const { return (const float*)(const __attribute__((address_space(1))) float*)ld(i); }
    __device__ __forceinline__ float* out() const { return (float*)(__attribute__((address_space(1))) float*)ld(34); }
    __device__ __forceinline__ unsigned char* ws() const { return (unsigned char*)(__attribute__((address_space(1))) unsigned char*)ld(35); }
};

__device__ __forceinline__ float bf2f(bf16_t b) { return __uint_as_float(((unsigned)b) << 16); }
__device__ __forceinline__ bf16_t f2bf(float f) { unsigned u = __float_as_uint(f); u += 0x7FFFu + ((u >> 16) & 1u); return (bf16_t)(u >> 16); }
__device__ __forceinline__ unsigned pk2(float lo, float hi) { return pg8::cvt_pk_bf16(lo, hi); }
__device__ __forceinline__ float sigm(float x) { return __builtin_amdgcn_rcpf(1.0f + __expf(-x)); }
__device__ __forceinline__ float silu(float x) { return x * __builtin_amdgcn_rcpf(1.0f + __expf(-x)); }
template <int CTRL> __device__ __forceinline__ float dpp_mov(float v) { return __int_as_float(__builtin_amdgcn_update_dpp(0, __float_as_int(v), CTRL, 0xF, 0xF, true)); }
__device__ __forceinline__ float wave_sum(float v) {
    v += dpp_mov<0xB1>(v); v += dpp_mov<0x4E>(v); v += dpp_mov<0x141>(v); v += dpp_mov<0x140>(v);
    v += __int_as_float(__builtin_amdgcn_update_dpp(0, __float_as_int(v), 0x142, 0xa, 0xf, false));
    v += __int_as_float(__builtin_amdgcn_update_dpp(0, __float_as_int(v), 0x143, 0xc, 0xf, false));
    return __int_as_float(__builtin_amdgcn_readlane(__float_as_int(v), 63));
}
#define LDS_WAIT() asm volatile("s_waitcnt lgkmcnt(0)" ::: "memory")
__device__ __forceinline__ void lds_barrier() { asm volatile("s_waitcnt lgkmcnt(0)" ::: "memory"); __builtin_amdgcn_s_barrier(); asm volatile("" ::: "memory"); }

struct EpiSwiglu {
    static constexpr bool PERM = true, AFTER_DRAIN = false;
    bf16_t* O;
    __device__ __forceinline__ void operator()(const f32x4 (&acc)[2][2][4][2], const pg8::Unit& u, int wr, int wc, int fr, int fq) const {
        const int row0 = u.pm * 256 + wr * 64 + fr, col0 = u.pn * 128 + wc * 32 + 8 * fq;
#pragma unroll
        for (int ai = 0; ai < 2; ++ai)
#pragma unroll
            for (int m = 0; m < 4; ++m) {
                bf16_t* p = O + (size_t)(row0 + ai * 128 + m * 16) * FF + col0;
                const f32x4 g0 = acc[ai][0][m][0], g1 = acc[ai][0][m][1], u0 = acc[ai][1][m][0], u1 = acc[ai][1][m][1];
                u32x4 w;
                w.x = pk2(silu(g0[0]) * u0[0], silu(g0[1]) * u0[1]); w.y = pk2(silu(g0[2]) * u0[2], silu(g0[3]) * u0[3]);
                w.z = pk2(silu(g1[0]) * u1[0], silu(g1[1]) * u1[1]); w.w = pk2(silu(g1[2]) * u1[2], silu(g1[3]) * u1[3]);
                *(u32x4*)p = w;
            }
    }
};
struct EpiResid {
    static constexpr bool PERM = false, AFTER_DRAIN = false;
    float* X; const float* Xs; float scale;
    __device__ __forceinline__ void operator()(const f32x4 (&acc)[2][2][4][2], const pg8::Unit& u, int wr, int wc, int fr, int fq) const {
        const int row0 = u.pm * 256 + wr * 64 + fr, col0 = u.pn * 256 + wc * 32 + 4 * fq;
#pragma unroll
        for (int ai = 0; ai < 2; ++ai)
#pragma unroll
            for (int m = 0; m < 4; ++m) {
                const size_t ro = (size_t)(row0 + ai * 128 + m * 16) * D + col0;
#pragma unroll
                for (int bj = 0; bj < 2; ++bj)
#pragma unroll
                    for (int n = 0; n < 2; ++n) { const size_t o = ro + bj * 128 + n * 16; *(f32x4*)(X + o) = *(const f32x4*)(Xs + o) + acc[ai][bj][m][n] * scale; }
            }
    }
};
struct EpiProj {
    static constexpr bool PERM = true, AFTER_DRAIN = false;
    bf16_t *PR, *PH, *PG;
    __device__ __forceinline__ void operator()(const f32x4 (&acc)[2][2][4][2], const pg8::Unit& u, int wr, int wc, int fr, int fq) const {
        bf16_t* base; int pitch, colt;
        if (u.pn < 6) { base = PR; pitch = PRW; colt = 256 * u.pn; }
        else if (u.pn < 12) { base = PH; pitch = PHG; colt = 256 * (u.pn - 6); }
        else { base = PG; pitch = PGL; colt = 256 * (u.pn - 12); }
        const int row0 = u.pm * 256 + wr * 64 + fr, col0 = colt + wc * 32 + 8 * fq;
#pragma unroll
        for (int ai = 0; ai < 2; ++ai)
#pragma unroll
            for (int m = 0; m < 4; ++m) {
                bf16_t* rowp = base + (size_t)(row0 + ai * 128 + m * 16) * pitch + col0;
#pragma unroll
                for (int bj = 0; bj < 2; ++bj) {
                    const f32x4 v0 = acc[ai][bj][m][0], v1 = acc[ai][bj][m][1];
                    u32x4 w; w.x = pk2(v0[0], v0[1]); w.y = pk2(v0[2], v0[3]); w.z = pk2(v1[0], v1[1]); w.w = pk2(v1[2], v1[3]);
                    *(u32x4*)(rowp + bj * 128) = w;
                }
            }
    }
};

__device__ __forceinline__ void tr_item(const float* W, int K, int N, bf16_t* WT, int rowbase, int k0, int n0, LAS float* scr, int lane) {
    const int n = n0 + (lane & 31);
    float tv[32];
#pragma unroll
    for (int i = 0; i < 32; ++i) { const int kk = 2 * i + (lane >> 5); tv[i] = 0.f; if (n < N) tv[i] = W[(size_t)(k0 + kk) * N + n]; }
#pragma unroll
    for (int i = 0; i < 32; ++i) { const int kk = 2 * i + (lane >> 5); scr[kk * 33 + (lane & 31)] = tv[i]; }
    LDS_WAIT();
    const int c = lane & 7;
#pragma unroll
    for (int j = 0; j < 4; ++j) {
        const int nn = (lane >> 3) + 8 * j; const LAS float* s = scr + (8 * c) * 33 + nn;
        u32x4 o; o.x = pk2(s[0 * 33], s[1 * 33]); o.y = pk2(s[2 * 33], s[3 * 33]); o.z = pk2(s[4 * 33], s[5 * 33]); o.w = pk2(s[6 * 33], s[7 * 33]);
        *(u32x4*)(WT + (size_t)(rowbase + nn) * K + k0 + 8 * c) = o;
    }
    LDS_WAIT();
}

__device__ __forceinline__ void phase_convert(const Params& p, int l, LAS unsigned char* lds, int gw, int ngw, int wave, int lane) {
    LAS float* scr = (LAS float*)(lds + wave * 8704);
    unsigned char* ws = p.ws();
    constexpr int I_UP = 16 * 88, I_DN = 44 * 32, I_IN = 16 * 129, I_VR = 16, I_OUT = 16 * 32, I_Z = 192;
    constexpr int NIT = 4 * I_UP + 2 * I_DN + I_IN + I_VR + I_OUT + I_Z;
    for (int it = gw; it < NIT; it += ngw) {
        int r = it;
        if (r < 4 * I_UP) {
            const int which = r / I_UP; r -= which * I_UP;
            const int src = (which == 0) ? 2 : (which == 1) ? 3 : (which == 2) ? 30 : 31;
            bf16_t* dst = (bf16_t*)(ws + ((which < 2) ? WS_WUP1 : WS_WUP2));
            const int kb = r / 88, nb = r % 88, n0 = 32 * nb;
            const int rowbase = 256 * (n0 / 128) + (n0 % 128) + ((which & 1) ? 128 : 0);
            tr_item(p.in(src) + (size_t)l * D * FF, D, FF, dst, rowbase, 64 * kb, n0, scr, lane);
            continue;
        }
        r -= 4 * I_UP;
        if (r < 2 * I_DN) {
            const int which = r / I_DN; r -= which * I_DN;
            const int kb = r / 32, nb = r % 32;
            tr_item(p.in(which ? 32 : 4) + (size_t)l * FF * D, FF, D, (bf16_t*)(ws + (which ? WS_WDN2 : WS_WDN1)), 32 * nb, 64 * kb, 32 * nb, scr, lane);
            continue;
        }
        r -= 2 * I_DN;
        if (r < I_IN) {
            const int kb = r / 129, nb = r % 129, n0 = 32 * nb;
            const int rowbase = n0 < 1408 ? n0 : (n0 < 2944 ? 1536 + (n0 - 1408) : 3072 + (n0 - 2944));
            tr_item(p.in(6) + (size_t)l * D * NIN, D, NIN, (bf16_t*)(ws + WS_WIN), rowbase, 64 * kb, n0, scr, lane);
            continue;
        }
        r -= I_IN;
        if (r < I_VR) {
            const int lv = l > 0 ? l - 1 : 0;
            tr_item(p.in(19) + (size_t)lv * D * 32, D, l > 0 ? 32 : 0, (bf16_t*)(ws + WS_WIN), 1408, 64 * r, 0, scr, lane);
            continue;
        }
        r -= I_VR;
        if (r < I_OUT) {
            const int kb = r / 32, nb = r % 32;
            tr_item(p.in(7) + (size_t)l * D * D, D, D, (bf16_t*)(ws + WS_WOUT), 32 * nb, 64 * kb, 32 * nb, scr, lane);
            continue;
        }
        r -= I_OUT;
        {
            const int row = r < 96 ? 1440 + r : 4256 + (r - 96);
            u32x4* q = (u32x4*)((bf16_t*)(ws + WS_WIN) + (size_t)row * D);
            const u32x4 z = {0u, 0u, 0u, 0u};
            q[lane] = z; q[64 + lane] = z;
        }
    }
    {
        bf16_t* LW = (bf16_t*)(ws + WS_LW); bf16_t* LA = (bf16_t*)(ws + WS_LA); bf16_t* LG = (bf16_t*)(ws + WS_LG); bf16_t* LV = (bf16_t*)(ws + WS_LV);
        const float* wu = p.in(10) + (size_t)l * 64 * RWW; const float* au = p.in(12) + (size_t)l * 64 * RWW; const float* gu = p.in(13) + (size_t)l * 128 * RWW;
        const float* vu = p.in(22) + (size_t)(l > 0 ? l - 1 : 0) * 32 * RWW;
        for (int idx = gw * 64 + lane; idx < 110592; idx += ngw * 64) {
            if (idx < 24576) { const int c = idx >> 6, k = idx & 63; LW[idx] = f2bf(wu[k * RWW + c]); }
            else if (idx < 49152) { const int i = idx - 24576, c = i >> 6, k = i & 63; LA[i] = f2bf(au[k * RWW + c]); }
            else if (idx < 98304) { const int i = idx - 49152, c = i >> 7, k = i & 127; LG[i] = f2bf(gu[k * RWW + c]); }
            else { const int i = idx - 98304, c = i >> 5, k = i & 31; LV[i] = (l > 0) ? f2bf(vu[k * RWW + c]) : (bf16_t)0; }
        }
    }
}

__device__ __forceinline__ void phase_norm(const float* x, const float* gain, bf16_t* h, int gw, int ngw, int lane) {
    f32x4 gv[4];
#pragma unroll
    for (int j = 0; j < 4; ++j) gv[j] = *(const f32x4*)(gain + j * 256 + lane * 4);
    for (int row = gw; row < T; row += 4 * ngw) {
        int rr[4]; f32x4 v[4][4]; float ss[4];
#pragma unroll
        for (int r = 0; r < 4; ++r) { rr[r] = (row + r * ngw < T) ? row + r * ngw : row; }
#pragma unroll
        for (int r = 0; r < 4; ++r)
#pragma unroll
            for (int j = 0; j < 4; ++j) v[r][j] = ((const f32x4*)(x + (size_t)rr[r] * D) + lane)[64 * j];
#pragma unroll
        for (int r = 0; r < 4; ++r) { float q = 0.f;
#pragma unroll
            for (int j = 0; j < 4; ++j) q += (v[r][j].x * v[r][j].x + v[r][j].y * v[r][j].y) + (v[r][j].z * v[r][j].z + v[r][j].w * v[r][j].w);
            ss[r] = q; }
#pragma unroll
        for (int r = 0; r < 4; ++r) {
            const float rs = rsqrtf(wave_sum(ss[r]) * (1.0f / D) + 1e-5f);
            unsigned long long* o8 = (unsigned long long*)(h + (size_t)rr[r] * D) + lane;
#pragma unroll
            for (int j = 0; j < 4; ++j) { const f32x4 y = v[r][j] * rs * gv[j]; o8[64 * j] = (unsigned long long)pk2(y.x, y.y) | ((unsigned long long)pk2(y.z, y.w) << 32); }
        }
    }
}
__device__ __forceinline__ void phase_final_norm(const float* x, const float* gain, float* out, int gw, int ngw, int lane) {
    f32x4 gv[4];
#pragma unroll
    for (int j = 0; j < 4; ++j) gv[j] = *(const f32x4*)(gain + j * 256 + lane * 4);
    for (int row = gw; row < T; row += ngw) {
        const f32x4* xr = (const f32x4*)(x + (size_t)row * D) + lane;
        f32x4 v[4]; float s = 0.f;
#pragma unroll
        for (int j = 0; j < 4; ++j) { v[j] = xr[64 * j]; s += (v[j].x * v[j].x + v[j].y * v[j].y) + (v[j].z * v[j].z + v[j].w * v[j].w); }
        const float rstd = rsqrtf(wave_sum(s) * (1.0f / D) + 1e-5f);
        f32x4* o = (f32x4*)(out + (size_t)row * D) + lane;
#pragma unroll
        for (int j = 0; j < 4; ++j) o[64 * j] = v[j] * rstd * gv[j];
    }
}

__device__ __forceinline__ void phase_rwprep(const Params& p, int l, LAS unsigned char* lds, int tid, int lane, int wave) {
    constexpr int APITCH = 296, OUT_OFF = 16384;
    LAS bf16_t* Aimg = (LAS bf16_t*)lds;
    LAS float* outL = (LAS float*)(lds + OUT_OFF);
    unsigned char* ws = p.ws();
    const bf16_t* PR = (const bf16_t*)(ws + WS_PRW);
    bf16_t* Rr = (bf16_t*)(ws + WS_R); bf16_t* Kk = (bf16_t*)(ws + WS_K); bf16_t* Vv = (bf16_t*)(ws + WS_V);
    bf16_t* Be = (bf16_t*)(ws + WS_BE); bf16_t* Al = (bf16_t*)(ws + WS_AL); bf16_t* Gg = (bf16_t*)(ws + WS_G);
    bf16_t* VF = (bf16_t*)(ws + WS_VF);
    float* Ww = (float*)(ws + WS_W); float* RK = (float*)(ws + WS_RK);
    const bf16_t* LW = (const bf16_t*)(ws + WS_LW); const bf16_t* LA = (const bf16_t*)(ws + WS_LA);
    const bf16_t* LG = (const bf16_t*)(ws + WS_LG); const bf16_t* LV = (const bf16_t*)(ws + WS_LV);
    const float* mu = p.in(8) + l * 1408;
    const int lv = l > 0 ? l - 1 : 0;
    const float* vmu = p.in(20) + lv * 32;
    for (int tile = blockIdx.x; tile < T / 16; tile += gridDim.x) {
        const int t0 = tile * 16;
        lds_barrier();
        {
            bf16_t cu_[9], pv_[9]; float mu_[9];
#pragma unroll
            for (int e = 0; e < 9; ++e) {
                const int idx = tid + 512 * e, t = idx / 288, j = idx % 288, tok = t0 + t;
                const int col = j < 256 ? 1152 + j : 1408 + (j - 256);
                const bf16_t* q = PR + (size_t)tok * PRW + col;
                cu_[e] = q[0];
                pv_[e] = tok > 0 ? q[-PRW] : (bf16_t)0;
                mu_[e] = j < 256 ? mu[col] : vmu[j - 256];
            }
#pragma unroll
            for (int e = 0; e < 9; ++e) {
                const int idx = tid + 512 * e, t = idx / 288, j = idx % 288;
                const float cur = bf2f(cu_[e]), prev = bf2f(pv_[e]);
                const float z = cur + (prev - cur) * mu_[e];
                float val = j < 64 ? tanhf(z) : (j < 128 ? z : (j < 256 ? sigm(z) : (l > 0 ? z : 0.f)));
                Aimg[t * APITCH + j] = f2bf(val);
            }
        }
        lds_barrier();
        {
            const int row = lane & 15, q = lane >> 4;
            pg8::bf16x8 af[9];
#pragma unroll
            for (int kc = 0; kc < 9; ++kc) af[kc] = *(const LAS pg8::bf16x8*)(Aimg + row * APITCH + 32 * kc + 8 * q);
#pragma unroll
            for (int ci = 0; ci < 3; ++ci) {
                const int ct = wave + 8 * ci, col = 16 * ct + row;
                f32x4 aw = {0.f, 0.f, 0.f, 0.f}, aa = aw, ag = aw, av = aw;
#pragma unroll
                for (int kc = 0; kc < 2; ++kc) {
                    aw = __builtin_amdgcn_mfma_f32_16x16x32_bf16(af[kc], *(const pg8::bf16x8*)(LW + (size_t)col * 64 + 32 * kc + 8 * q), aw, 0, 0, 0);
                    aa = __builtin_amdgcn_mfma_f32_16x16x32_bf16(af[2 + kc], *(const pg8::bf16x8*)(LA + (size_t)col * 64 + 32 * kc + 8 * q), aa, 0, 0, 0);
                }
#pragma unroll
                for (int kc = 0; kc < 4; ++kc)
                    ag = __builtin_amdgcn_mfma_f32_16x16x32_bf16(af[4 + kc], *(const pg8::bf16x8*)(LG + (size_t)col * 128 + 32 * kc + 8 * q), ag, 0, 0, 0);
                if (l > 0) av = __builtin_amdgcn_mfma_f32_16x16x32_bf16(af[8], *(const pg8::bf16x8*)(LV + (size_t)col * 32 + 8 * q), av, 0, 0, 0);
#pragma unroll
                for (int i = 0; i < 4; ++i) {
                    const int o = (4 * q + i) * RWW + col;
                    outL[0 * 16 * RWW + o] = aw[i]; outL[1 * 16 * RWW + o] = aa[i]; outL[2 * 16 * RWW + o] = ag[i]; outL[3 * 16 * RWW + o] = av[i];
                }
            }
        }
        lds_barrier();
        if (tid < RWW) {
            const int c = tid, h = tid >> 6;
            const float w0c = p.in(9)[l * RWW + c], a0c = p.in(11)[l * RWW + c];
            const float v0c = l > 0 ? p.in(21)[lv * RWW + c] : 0.f;
            const float mur = mu[c], muk = mu[384 + c], muv = mu[768 + c];
            const float kkc = p.in(14)[l * RWW + c], kac = p.in(15)[l * RWW + c], rkc = p.in(16)[l * RWW + c];
            bf16_t rr_[17], kr_[17], vr_[17], vf_[16];
#pragma unroll
            for (int t = 0; t < 17; ++t) {
                const int tok = t0 - 1 + t;
                if (tok >= 0) { const bf16_t* qq = PR + (size_t)tok * PRW + c; rr_[t] = qq[0]; kr_[t] = qq[384]; vr_[t] = qq[768]; }
                else { rr_[t] = 0; kr_[t] = 0; vr_[t] = 0; }
            }
#pragma unroll
            for (int t = 0; t < 16; ++t) vf_[t] = (l > 0) ? VF[(size_t)(t0 + t) * RWW + c] : (bf16_t)0;
#pragma unroll
            for (int t = 0; t < 16; ++t) {
                const int tok = t0 + t;
                const float rc = bf2f(rr_[t + 1]), kc = bf2f(kr_[t + 1]), vc = bf2f(vr_[t + 1]);
                const float rp = bf2f(rr_[t]), kp = bf2f(kr_[t]), vp = bf2f(vr_[t]);
                const float r = rc + (rp - rc) * mur, k = kc + (kp - kc) * muk;
                float v = vc + (vp - vc) * muv;
                const size_t o = (size_t)tok * RWW + c;
                const float lw = w0c + outL[0 * 16 * RWW + t * RWW + c];
                const float a = sigm(a0c + outL[1 * 16 * RWW + t * RWW + c]);
                const float g = outL[2 * 16 * RWW + t * RWW + c];
                if (l == 0) VF[o] = f2bf(v);
                else { const float vf = bf2f(vf_[t]); v = v + (vf - v) * sigm(v0c + outL[3 * 16 * RWW + t * RWW + c]); }
                const float kk = k * kkc;
                const float n2 = wave_sum(kk * kk);
                const float kkn = kk * rsqrtf(fmaxf(n2, 1e-24f));
                const float kmod = k * (1.0f + (a - 1.0f) * kac);
                const float rks = wave_sum(r * kmod * rkc);
                Ww[o] = __expf(-0.60653066f * sigm(lw));
                Gg[o] = f2bf(g);
                Rr[o] = f2bf(r); Kk[o] = f2bf(kmod); Vv[o] = f2bf(v); Be[o] = f2bf(kkn); Al[o] = f2bf(kkn * a);
                if (lane == 0) RK[(size_t)tok * 8 + h] = rks;
            }
        }
    }
}

constexpr int TP = 40;
template <int KQ> __device__ __forceinline__ float kq_sum(float v) {
    v += dpp_mov<0xB1>(v); v += dpp_mov<0x4E>(v); v += dpp_mov<0x141>(v);
    if (KQ == 16) v += dpp_mov<0x140>(v);
    return v;
}

__device__ __forceinline__ void kq_sum16x4(float& a, float& b, float& c, float& d) {
    a += dpp_mov<0xB1>(a); b += dpp_mov<0xB1>(b); c += dpp_mov<0xB1>(c); d += dpp_mov<0xB1>(d);
    a += dpp_mov<0x4E>(a); b += dpp_mov<0x4E>(b); c += dpp_mov<0x4E>(c); d += dpp_mov<0x4E>(d);
    a += dpp_mov<0x141>(a); b += dpp_mov<0x141>(b); c += dpp_mov<0x141>(c); d += dpp_mov<0x141>(d);
    a += dpp_mov<0x140>(a); b += dpp_mov<0x140>(b); c += dpp_mov<0x140>(c); d += dpp_mov<0x140>(d);
}
template <int pass>
__device__ __forceinline__ void rw_item(const Params& p, int l, int seg, int h, LAS float* sm, int tid, int lane, int wave) {
    unsigned char* ws = p.ws();
    const bf16_t* Rr = (const bf16_t*)(ws + WS_R); const bf16_t* Kk = (const bf16_t*)(ws + WS_K); const bf16_t* Vv = (const bf16_t*)(ws + WS_V);
    const bf16_t* Be = (const bf16_t*)(ws + WS_BE); const bf16_t* Al = (const bf16_t*)(ws + WS_AL); const bf16_t* Gg = (const bf16_t*)(ws + WS_G);
    const float* Ww = (const float*)(ws + WS_W); const float* RK = (const float*)(ws + WS_RK);
    float* Lm = (float*)(ws + WS_RWL); float* Pm = (float*)(ws + WS_RWP);
    bf16_t* MX = (bf16_t*)(ws + WS_H);
    const int kq = tid & 15, jp = tid >> 4, j0 = 2 * jp, j1 = 2 * jp + 1;
    f32x2 sA[2], sB[2], pA[2], pB[2];
#pragma unroll
    for (int i = 0; i < 2; ++i) {
        sA[i] = (f32x2){0.f, 0.f}; sB[i] = (f32x2){0.f, 0.f};
        pA[i] = (f32x2){(kq * 4 + 2 * i == j0) ? 1.f : 0.f, (kq * 4 + 2 * i + 1 == j0) ? 1.f : 0.f};
        pB[i] = (f32x2){(kq * 4 + 2 * i == j1) ? 1.f : 0.f, (kq * 4 + 2 * i + 1 == j1) ? 1.f : 0.f};
    }
    if (pass == 1 && seg > 0) {
        const float* q = Lm + ((size_t)((seg - 1) * 6 + h) * 64 + j0) * 64 + kq * 4;
        const f32x4 a = *(const f32x4*)q, b = *(const f32x4*)(q + 64);
        sA[0] = a.xy; sA[1] = a.zw; sB[0] = b.xy; sB[1] = b.zw;
    }
    float lnw = 0.f, lnb = 0.f;
    if (pass == 1) { lnw = p.in(17)[l * RWW + h * 64 + lane]; lnb = p.in(18)[l * RWW + h * 64 + lane]; }
    float rw_[2]; bf16_t rk_[2], ra_[2], rb_[2], rv_[2], rq_[2];
    const size_t gbase = (size_t)(seg * SEG) * RWW + h * 64 + (tid & 63);
    const int trow = tid >> 6;
#define RW_LOAD(sb) do { _Pragma("unroll") for (int e = 0; e < 2; ++e) { const size_t g = gbase + (size_t)((sb) * TS + trow + 8 * e) * RWW; \
        rw_[e] = Ww[g]; rk_[e] = Kk[g]; ra_[e] = Al[g]; rb_[e] = Be[g]; rv_[e] = Vv[g]; if (pass == 1) rq_[e] = Rr[g]; } } while (0)
#define RW_STORE(buf) do { _Pragma("unroll") for (int e = 0; e < 2; ++e) { LAS float* b_ = sm + (buf) * 6144 + tid + 512 * e; \
        b_[1024] = rw_[e]; b_[2048] = bf2f(rk_[e]); b_[3072] = bf2f(ra_[e]); b_[4096] = bf2f(rb_[e]); b_[5120] = bf2f(rv_[e]); if (pass == 1) b_[0] = bf2f(rq_[e]); } } while (0)
    lds_barrier();
    RW_LOAD(0); RW_STORE(0); RW_LOAD(1);
    lds_barrier();
    for (int sb = 0; sb < SEG / TS; ++sb) {
        const int cur = sb & 1;
        const LAS float* bf = sm + cur * 6144;
        LAS float* ob = sm + 12288 + cur * 1024;
        float pf_rk[2] = {0.f, 0.f}; bf16_t pf_v[2] = {0, 0}, pf_g[2] = {0, 0};
        if (pass == 1) {
#pragma unroll
            for (int rr = 0; rr < 2; ++rr) { const int tok = seg * SEG + sb * TS + wave + 8 * rr; const size_t g = (size_t)tok * RWW + h * 64 + lane; pf_rk[rr] = RK[(size_t)tok * 8 + h]; pf_v[rr] = Vv[g]; pf_g[rr] = Gg[g]; }
        }
        f32x4 nw4 = *(const LAS f32x4*)(bf + 1024 + kq * 4), nk4 = *(const LAS f32x4*)(bf + 2048 + kq * 4);
        f32x4 na4 = *(const LAS f32x4*)(bf + 3072 + kq * 4), nb4 = *(const LAS f32x4*)(bf + 4096 + kq * 4);
        f32x2 nvv = *(const LAS f32x2*)(bf + 5120 + j0);
        f32x4 nq4 = (pass == 1) ? *(const LAS f32x4*)(bf + kq * 4) : (f32x4){0.f, 0.f, 0.f, 0.f};
#pragma unroll 4
        for (int t = 0; t < TS; ++t) {
            const f32x4 w4 = nw4, k4 = nk4, a4 = na4, b4 = nb4, q4 = nq4; const f32x2 vv = nvv;
            {
                const int tn = (t + 1 < TS) ? t + 1 : t, on = tn * 64 + kq * 4;
                nw4 = *(const LAS f32x4*)(bf + 1024 + on); nk4 = *(const LAS f32x4*)(bf + 2048 + on);
                na4 = *(const LAS f32x4*)(bf + 3072 + on); nb4 = *(const LAS f32x4*)(bf + 4096 + on);
                nvv = *(const LAS f32x2*)(bf + 5120 + tn * 64 + j0);
                if (pass == 1) nq4 = *(const LAS f32x4*)(bf + on);
            }
            const f32x2 vA = {vv.x, vv.x}, vB = {vv.y, vv.y};
            f32x2 ua = b4.xy * sA[0], ub = b4.xy * sB[0];
            ua = b4.zw * sA[1] + ua; ub = b4.zw * sB[1] + ub;
            float uA = ua.x + ua.y, uB = ub.x + ub.y, gA = 0.f, gB = 0.f;
            if (pass == 0) {
                f32x2 qa = b4.xy * pA[0], qb = b4.xy * pB[0];
                qa = b4.zw * pA[1] + qa; qb = b4.zw * pB[1] + qb;
                gA = qa.x + qa.y; gB = qb.x + qb.y;
                kq_sum16x4(uA, uB, gA, gB);
            } else { uA = kq_sum<16>(uA); uB = kq_sum<16>(uB); }
            const f32x2 uA2 = {uA, uA}, uB2 = {uB, uB};
            { const f32x2 t0_ = k4.xy * vA - a4.xy * uA2, t1_ = k4.zw * vA - a4.zw * uA2; sA[0] = w4.xy * sA[0] + t0_; sA[1] = w4.zw * sA[1] + t1_; }
            { const f32x2 t0_ = k4.xy * vB - a4.xy * uB2, t1_ = k4.zw * vB - a4.zw * uB2; sB[0] = w4.xy * sB[0] + t0_; sB[1] = w4.zw * sB[1] + t1_; }
            if (pass == 0) {
                const f32x2 gA2 = {gA, gA}, gB2 = {gB, gB};
                pA[0] = w4.xy * pA[0] - a4.xy * gA2; pA[1] = w4.zw * pA[1] - a4.zw * gA2;
                pB[0] = w4.xy * pB[0] - a4.xy * gB2; pB[1] = w4.zw * pB[1] - a4.zw * gB2;
            } else {
                f32x2 oa = q4.xy * sA[0], ob2 = q4.xy * sB[0];
                oa = q4.zw * sA[1] + oa; ob2 = q4.zw * sB[1] + ob2;
                const float oA = kq_sum<16>(oa.x + oa.y), oB = kq_sum<16>(ob2.x + ob2.y);
                if (kq == 0) *(LAS f32x2*)(ob + t * 64 + j0) = (f32x2){oA, oB};
            }
        }
        if (sb + 1 < SEG / TS) RW_STORE(cur ^ 1);
        if (sb + 2 < SEG / TS) RW_LOAD(sb + 2);
        lds_barrier();
        if (pass == 1) {
            const int t0 = seg * SEG + sb * TS;
#pragma unroll
            for (int rr = 0; rr < 2; ++rr) {
                const int t = wave + 8 * rr, tok = t0 + t, c = h * 64 + lane;
                const float y = ob[t * 64 + lane];
                const float mean = wave_sum(y) * (1.0f / 64.0f);
                const float d = y - mean;
                const float var = wave_sum(d * d) * (1.0f / 64.0f);
                const float yn = d * rsqrtf(var + 64e-5f);
                const float val = yn * lnw + lnb + pf_rk[rr] * bf2f(pf_v[rr]);
                MX[(size_t)tok * D + c] = f2bf(val * bf2f(pf_g[rr]));
            }
        }
    }
#undef RW_LOAD
#undef RW_STORE
    if (pass == 0) {
        float* ql = Lm + ((size_t)(seg * 6 + h) * 64 + j0) * 64 + kq * 4;
        *(f32x4*)ql = (f32x4){sA[0].x, sA[0].y, sA[1].x, sA[1].y}; *(f32x4*)(ql + 64) = (f32x4){sB[0].x, sB[0].y, sB[1].x, sB[1].y};
        float* qp = Pm + ((size_t)(seg * 6 + h) * 64 + j0) * 64 + kq * 4;
        *(f32x4*)qp = (f32x4){pA[0].x, pA[0].y, pA[1].x, pA[1].y}; *(f32x4*)(qp + 64) = (f32x4){pB[0].x, pB[0].y, pB[1].x, pB[1].y};
    }
}

__device__ __forceinline__ float bf_at(const u32x4& a, const u32x4& b, int i) {
    const unsigned w = (i < 8) ? a[(i >> 1) & 3] : b[(i >> 1) & 3];
    return __uint_as_float((i & 1) ? (w & 0xffff0000u) : (w << 16));
}
#define DG_LOAD(sb) do { const int t0_ = seg * SEG + (sb) * TS; \
        if (HG) { _Pragma("unroll") for (int e = 0; e < EQ; ++e) { const int idx = tid + 512 * e; const bf16_t* row = PH + (size_t)(t0_ + (idx >> 7)) * PHG + h * 128 + (idx & 127); rf[e] = row[512]; if (pass == 1) rq[e] = row[0]; } \
                  _Pragma("unroll") for (int e = 0; e < EV; ++e) { const int idx = tid + 512 * e; rv[e] = PH[(size_t)(t0_ + (idx >> 6)) * PHG + 1024 + h * 64 + (idx & 63)]; } } \
        else { _Pragma("unroll") for (int e = 0; e < EQ; ++e) { const int idx = tid + 512 * e; if (idx < NQK) { const int t = idx / 48, c = idx % 48, tok = t0_ + t; \
                    _Pragma("unroll") for (int jj = 0; jj < 4; ++jj) { const int tt = tok - 3 + jj; bf16_t a = 0, b = 0; if (tt >= 0) { const bf16_t* row = PG + (size_t)tt * PGL + h * 48 + c; a = row[192]; if (pass == 1) b = row[0]; } ck[e][jj] = a; cq[e][jj] = b; } \
                    const u32x4* gp = (const u32x4*)(PG + (size_t)tok * PGL + 768); g0[e] = gp[0]; g1[e] = gp[1]; } } \
               _Pragma("unroll") for (int e = 0; e < EV; ++e) { const int idx = tid + 512 * e; const int t = idx / 96, c = idx % 96, tok = t0_ + t; \
                    _Pragma("unroll") for (int jj = 0; jj < 4; ++jj) { const int tt = tok - 3 + jj; bf16_t a = 0; if (tt >= 0) a = PG[(size_t)tt * PGL + 384 + h * 96 + c]; cv[e][jj] = a; } } } } while (0)
#define DG_STORE(buf) do { LAS float* b_ = sm + (buf) * 7680; \
        if (HG) { _Pragma("unroll") for (int e = 0; e < EQ; ++e) { const int idx = tid + 512 * e; const float f = bf2f(rf[e]); const float lb = sm[L_LB2 + (idx & 127)]; \
                    const float sg = __builtin_amdgcn_rcpf(1.0f + __expf(-f)); b_[2048 + idx] = fmaxf(lb + (1.0f - lb) * sg, 1e-30f); b_[4096 + idx] = (1.0f - lb) * (1.0f - sg); if (pass == 1) b_[idx] = silu(bf2f(rq[e])); } \
                  _Pragma("unroll") for (int e = 0; e < EV; ++e) b_[6144 + tid + 512 * e] = bf2f(rv[e]); } \
        else { _Pragma("unroll") for (int e = 0; e < EQ; ++e) { const int idx = tid + 512 * e; if (idx < NQK) { \
                    const int c_ = idx % 48; float aq = 0.f, ak = 0.f; _Pragma("unroll") for (int jj = 0; jj < 4; ++jj) { ak += sm[L_CW + jj * 192 + 48 + c_] * bf2f(ck[e][jj]); if (pass == 1) aq += sm[L_CW + jj * 192 + c_] * bf2f(cq[e][jj]); } \
                    float x = sm[L_GB + c_]; _Pragma("unroll") for (int i = 0; i < 16; ++i) x += bf_at(g0[e], g1[e], i) * sm[L_GUP + i * 48 + c_]; \
                    const float ls = fminf(x, 0.f) - __logf(1.0f + __expf(-fabsf(x))); \
                    b_[2048 + idx] = __expf(ls * (1.0f / 16.0f)); b_[4096 + idx] = silu(ak); if (pass == 1) b_[idx] = silu(aq) * 0.14433756729740643f; } } \
               _Pragma("unroll") for (int e = 0; e < EV; ++e) { const int c_ = (tid + 512 * e) % 96; float av = 0.f; _Pragma("unroll") for (int jj = 0; jj < 4; ++jj) av += sm[L_CW + jj * 192 + 96 + c_] * bf2f(cv[e][jj]); b_[6144 + tid + 512 * e] = silu(av); } } } while (0)

template <bool HG, int pass>
__device__ __forceinline__ void diag_item(const Params& p, int l, int seg, int h, LAS float* sm, int tid, int lane, int wave) {
    constexpr int K = HG ? 128 : 48, V = HG ? 64 : 96, KQ = HG ? 16 : 8, KPT = K / KQ, NP = KPT / 2;
    constexpr int NQK = TS * K, NV = TS * V, EQ = (NQK + 511) / 512, EV = (NV + 511) / 512;
    constexpr int L_LB2 = 18432;
    unsigned char* ws = p.ws();
    const bf16_t* PH = (const bf16_t*)(ws + WS_PHG); const bf16_t* PG = (const bf16_t*)(ws + WS_PGL);
    float* Lm = (float*)(ws + (HG ? WS_HGL : WS_GLL)); float* Dm = (float*)(ws + (HG ? WS_HGD : WS_GLD));
    bf16_t* MX = (bf16_t*)(ws + WS_H);
    const int kq = tid % KQ, jp = tid / KQ, j0 = 2 * jp;
    const bool active = j0 < V;
    f32x2 sA[NP], sB[NP], dt2[NP];
#pragma unroll
    for (int i = 0; i < NP; ++i) { sA[i] = (f32x2){0.f, 0.f}; sB[i] = (f32x2){0.f, 0.f}; dt2[i] = (f32x2){1.f, 1.f}; }
    if (pass == 1 && seg > 0 && active) {
        const float* q = Lm + ((size_t)((seg - 1) * 4 + h) * V + j0) * K + kq * KPT;
#pragma unroll
        for (int i = 0; i < NP; ++i) { sA[i] = *(const f32x2*)(q + 2 * i); sB[i] = *(const f32x2*)(q + K + 2 * i); }
    }
    float gn1 = 0.f, gn2 = 0.f;
    if (pass == 1) {
        if (HG) gn1 = p.in(24)[l * 256 + h * 64 + lane];
        else { gn1 = p.in(28)[l * 384 + h * 96 + lane]; gn2 = lane < 32 ? p.in(28)[l * 384 + h * 96 + 64 + lane] : 0.f; }
    }
    bf16_t rf[EQ], rq[EQ], rv[EV];
    bf16_t cq[EQ][4], ck[EQ][4], cv[EV][4];
    u32x4 g0[EQ], g1[EQ];
    constexpr int L_GUP = 18560, L_CW = 19328, L_GB = 20096;
    lds_barrier();
    if (HG) {
        if (tid < 128) {
            const float* lg = p.in(23) + h * 128 + tid;
            const float x0 = lg[0], x1 = lg[512], x2 = lg[1024], x3 = lg[1536];
            const float m = fmaxf(fmaxf(x0, x1), fmaxf(x2, x3));
            const float e0 = __expf(x0 - m), e1 = __expf(x1 - m), e2 = __expf(x2 - m), e3 = __expf(x3 - m);
            const float inv = 1.0f / (e0 + e1 + e2 + e3);
            float lb = 0.f;
            if (l >= 1) lb += e1; if (l >= 2) lb += e2; if (l >= 3) lb += e3;
            sm[L_LB2 + tid] = lb * inv;
        }
    } else {
        const float* cw = p.in(25) + (size_t)l * 4 * 768;
        for (int i = tid; i < 768; i += 512) { const int r = i / 48, c = i % 48; sm[L_GUP + i] = p.in(26)[(size_t)l * 16 * 192 + r * 192 + h * 48 + c]; }
        for (int i = tid; i < 768; i += 512) { const int jj = i / 192, c = i % 192; const int ch = c < 48 ? h * 48 + c : (c < 96 ? 192 + h * 48 + (c - 48) : 384 + h * 96 + (c - 96)); sm[L_CW + i] = cw[jj * 768 + ch]; }
        if (tid < 48) sm[L_GB + tid] = p.in(27)[l * 192 + h * 48 + tid];
    }
    DG_LOAD(0);
    lds_barrier();
    DG_STORE(0); DG_LOAD(1);
    lds_barrier();
    for (int sb = 0; sb < SEG / TS; ++sb) {
        const int cur = sb & 1;
        const LAS float* bf = sm + cur * 7680;
        LAS float* ob = sm + 15360 + cur * 1536;
        bf16_t pf_g1[2] = {0, 0}, pf_g2[2] = {0, 0};
        if (pass == 1) {
#pragma unroll
            for (int rr = 0; rr < 2; ++rr) { const int tok = seg * SEG + sb * TS + wave + 8 * rr;
                if (HG) pf_g1[rr] = PH[(size_t)tok * PHG + 1280 + h * 64 + lane];
                else { const bf16_t* row = PG + (size_t)tok * PGL + 784 + h * 96; pf_g1[rr] = row[lane]; pf_g2[rr] = lane < 32 ? row[64 + lane] : (bf16_t)0; } }
        }
        if (active) {
#pragma unroll 4
            for (int t = 0; t < TS; ++t) {
                const int o = t * K + kq * KPT;
                const f32x2 vv = *(const LAS f32x2*)(bf + 6144 + t * V + j0);
                const f32x2 vA = {vv.x, vv.x}, vB = {vv.y, vv.y};
                f32x2 dv[NP];
#pragma unroll
                for (int i = 0; i < NP; ++i) {
                    dv[i] = *(const LAS f32x2*)(bf + 2048 + o + 2 * i);
                    const f32x2 kk = *(const LAS f32x2*)(bf + 4096 + o + 2 * i);
                    sA[i] = dv[i] * sA[i] + kk * vA; sB[i] = dv[i] * sB[i] + kk * vB;
                }
                if (pass == 0) {
                    if (jp == 0) {
#pragma unroll
                        for (int i = 0; i < NP; ++i) dt2[i] = dt2[i] * dv[i];
                    }
                } else {
                    f32x2 oa = {0.f, 0.f}, ob2 = {0.f, 0.f};
#pragma unroll
                    for (int i = 0; i < NP; ++i) { const f32x2 q = *(const LAS f32x2*)(bf + o + 2 * i); oa = q * sA[i] + oa; ob2 = q * sB[i] + ob2; }
                    const float oA = kq_sum<KQ>(oa.x + oa.y), oB = kq_sum<KQ>(ob2.x + ob2.y);
                    if (kq == 0) *(LAS f32x2*)(ob + t * V + j0) = (f32x2){oA, oB};
                }
            }
        }
        if (sb + 1 < SEG / TS) DG_STORE(cur ^ 1);
        if (sb + 2 < SEG / TS) DG_LOAD(sb + 2);
        lds_barrier();
        if (pass == 1) {
            const int t0 = seg * SEG + sb * TS;
#pragma unroll
            for (int rr = 0; rr < 2; ++rr) {
                const int t = wave + 8 * rr, tok = t0 + t;
                if (HG) {
                    const float y = ob[t * 64 + lane];
                    const float ms = wave_sum(y * y) * (1.0f / 64.0f);
                    const float yn = y * rsqrtf(ms + 1e-5f);
                    MX[(size_t)tok * D + 384 + h * 64 + lane] = f2bf(yn * gn1 * silu(bf2f(pf_g1[rr])));
                } else {
                    const float y1 = ob[t * 96 + lane];
                    const float y2 = lane < 32 ? ob[t * 96 + 64 + lane] : 0.f;
                    const float ms = wave_sum(y1 * y1 + y2 * y2) * (1.0f / 96.0f);
                    const float rs = rsqrtf(ms + 1e-5f);
                    bf16_t* mo = MX + (size_t)tok * D + 640 + h * 96;
                    mo[lane] = f2bf(y1 * rs * gn1 * silu(bf2f(pf_g1[rr])));
                    if (lane < 32) mo[64 + lane] = f2bf(y2 * rs * gn2 * silu(bf2f(pf_g2[rr])));
                }
            }
        }
    }
    if (pass == 0 && active) {
        float* q = Lm + ((size_t)(seg * 4 + h) * V + j0) * K + kq * KPT;
#pragma unroll
        for (int i = 0; i < NP; ++i) { *(f32x2*)(q + 2 * i) = sA[i]; *(f32x2*)(q + K + 2 * i) = sB[i]; }
        if (jp == 0) {
            float* qd = Dm + (size_t)(seg * 4 + h) * K + kq * KPT;
#pragma unroll
            for (int i = 0; i < NP; ++i) *(f32x2*)(qd + 2 * i) = dt2[i];
        }
    }
}


template <bool HG>
__device__ __forceinline__ void diag_item_A(const Params& p, int l, int seg, int h, LAS float* sm, int tid, int lane, int wave) {
    constexpr int pass = 0;
    constexpr int K = HG ? 128 : 48, V = HG ? 64 : 96;
    constexpr int NQK = TS * K, NV = TS * V, EQ = (NQK + 511) / 512, EV = (NV + 511) / 512;
    constexpr int L_LB2 = 18432, L_GUP = 18560, L_CW = 19328, L_GB = 20096, L_KT = 20480, L_VT = 23040;
    unsigned char* ws = p.ws();
    const bf16_t* PH = (const bf16_t*)(ws + WS_PHG); const bf16_t* PG = (const bf16_t*)(ws + WS_PGL);
    float* Lm = (float*)(ws + (HG ? WS_HGL : WS_GLL)); float* Dm = (float*)(ws + (HG ? WS_HGD : WS_GLD));
    LAS bf16_t* kT = (LAS bf16_t*)(sm + L_KT); LAS bf16_t* vT = (LAS bf16_t*)(sm + L_VT);
    bf16_t rf[EQ], rq[EQ], rv[EV];
    bf16_t cq[EQ][4], ck[EQ][4], cv[EV][4];
    u32x4 g0[EQ], g1[EQ];
    lds_barrier();
    if (HG) {
        if (tid < 128) {
            const float* lg = p.in(23) + h * 128 + tid;
            const float x0 = lg[0], x1 = lg[512], x2 = lg[1024], x3 = lg[1536];
            const float m = fmaxf(fmaxf(x0, x1), fmaxf(x2, x3));
            const float e0 = __expf(x0 - m), e1 = __expf(x1 - m), e2 = __expf(x2 - m), e3 = __expf(x3 - m);
            const float inv = 1.0f / (e0 + e1 + e2 + e3);
            float lb = 0.f;
            if (l >= 1) lb += e1; if (l >= 2) lb += e2; if (l >= 3) lb += e3;
            sm[L_LB2 + tid] = lb * inv;
        }
    } else {
        const float* cw = p.in(25) + (size_t)l * 4 * 768;
        for (int i = tid; i < 768; i += 512) { const int r = i / 48, c = i % 48; sm[L_GUP + i] = p.in(26)[(size_t)l * 16 * 192 + r * 192 + h * 48 + c]; }
        for (int i = tid; i < 768; i += 512) { const int jj = i / 192, c = i % 192; const int ch = c < 48 ? h * 48 + c : (c < 96 ? 192 + h * 48 + (c - 48) : 384 + h * 96 + (c - 96)); sm[L_CW + i] = cw[jj * 768 + ch]; }
        if (tid < 48) sm[L_GB + tid] = p.in(27)[l * 192 + h * 48 + tid];
    }
    for (int i = tid; i < (L_VT - L_KT) + V * TP / 2; i += 512) ((LAS unsigned*)(sm + L_KT))[i] = 0u;
    float R = 1.0f;
    f32x4 acc[4];
#pragma unroll
    for (int i = 0; i < 4; ++i) acc[i] = (f32x4){0.f, 0.f, 0.f, 0.f};
    const int row = lane & 15, q = lane >> 4;
    DG_LOAD(7);
    lds_barrier();
    DG_STORE(1); DG_LOAD(6);
    lds_barrier();
    for (int sbi = 0; sbi < SEG / TS; ++sbi) {
        const int sb = SEG / TS - 1 - sbi, cur = sb & 1;
        const LAS float* bf = sm + cur * 7680;
        if (tid < K) {
            float dd[TS], kk_[TS];
#pragma unroll
            for (int t = 0; t < TS; ++t) { dd[t] = bf[2048 + t * K + tid]; kk_[t] = bf[4096 + t * K + tid]; }
#pragma unroll
            for (int t = TS - 1; t >= 0; --t) { kT[tid * TP + t] = f2bf(kk_[t] * R); R *= dd[t]; }
        }
        { float vv_[EV];
#pragma unroll
          for (int e = 0; e < EV; ++e) vv_[e] = bf[6144 + tid + 512 * e];
#pragma unroll
          for (int e = 0; e < EV; ++e) { const int idx = tid + 512 * e; vT[(idx % V) * TP + (idx / V)] = f2bf(vv_[e]); } }
        lds_barrier();
        if (HG) {
            const pg8::bf16x8 a = *(const LAS pg8::bf16x8*)(kT + (16 * wave + row) * TP + 8 * q);
#pragma unroll
            for (int n = 0; n < 4; ++n) acc[n] = __builtin_amdgcn_mfma_f32_16x16x32_bf16(a, *(const LAS pg8::bf16x8*)(vT + (16 * n + row) * TP + 8 * q), acc[n], 0, 0, 0);
        } else if (wave < 6) {
            const pg8::bf16x8 b = *(const LAS pg8::bf16x8*)(vT + (16 * wave + row) * TP + 8 * q);
#pragma unroll
            for (int m = 0; m < 3; ++m) acc[m] = __builtin_amdgcn_mfma_f32_16x16x32_bf16(*(const LAS pg8::bf16x8*)(kT + (16 * m + row) * TP + 8 * q), b, acc[m], 0, 0, 0);
        }
        if (sbi + 1 < SEG / TS) DG_STORE(cur ^ 1);
        if (sbi + 2 < SEG / TS) DG_LOAD(sb - 2);
        lds_barrier();
    }
    float* Lb = Lm + (size_t)(seg * 4 + h) * V * K;
    if (HG) {
#pragma unroll
        for (int n = 0; n < 4; ++n) *(f32x4*)(Lb + (size_t)(16 * n + row) * K + 16 * wave + 4 * q) = acc[n];
    } else if (wave < 6) {
#pragma unroll
        for (int m = 0; m < 3; ++m) *(f32x4*)(Lb + (size_t)(16 * wave + row) * K + 16 * m + 4 * q) = acc[m];
    }
    if (tid < K) Dm[(size_t)(seg * 4 + h) * K + tid] = R;
}

__device__ __forceinline__ void hg_item_C(const Params& p, int l, int seg, int h, LAS float* sm, int tid, int lane, int wave) {
    constexpr bool HG = true; constexpr int pass = 1;
    constexpr int K = 128, V = 64;
    constexpr int NQK = TS * K, NV = TS * V, EQ = (NQK + 511) / 512, EV = (NV + 511) / 512;
    constexpr int L_LB2 = 18432, L_GUP = 18560, L_CW = 19328, L_GB = 20096;
    constexpr int L_QG = 20480, L_KT = 21568, L_VT = 24128, L_AM = 25408, L_SB = 25728, L_G15 = 30080, L_PART = 30208;
    constexpr int QP = 136, SP = 136;
    (void)L_GUP; (void)L_CW; (void)L_GB;
    unsigned char* ws = p.ws();
    const bf16_t* PH = (const bf16_t*)(ws + WS_PHG); const bf16_t* PG = (const bf16_t*)(ws + WS_PGL);
    const float* Lm = (const float*)(ws + WS_HGL);
    bf16_t* MX = (bf16_t*)(ws + WS_H);
    LAS bf16_t* qG = (LAS bf16_t*)(sm + L_QG); LAS bf16_t* kT = (LAS bf16_t*)(sm + L_KT); LAS bf16_t* vT = (LAS bf16_t*)(sm + L_VT);
    LAS bf16_t* Am = (LAS bf16_t*)(sm + L_AM); LAS bf16_t* Sb = (LAS bf16_t*)(sm + L_SB);
    LAS float* G15 = sm + L_G15; LAS float* part = sm + L_PART;
    bf16_t rf[EQ], rq[EQ], rv[EV];
    bf16_t cq[EQ][4], ck[EQ][4], cv[EV][4];
    u32x4 g0[EQ], g1[EQ];
    const int row = lane & 15, q = lane >> 4;
    const float gn1 = p.in(24)[l * 256 + h * 64 + lane];
    lds_barrier();
    if (tid < 128) {
        const float* lg = p.in(23) + h * 128 + tid;
        const float x0 = lg[0], x1 = lg[512], x2 = lg[1024], x3 = lg[1536];
        const float m = fmaxf(fmaxf(x0, x1), fmaxf(x2, x3));
        const float e0 = __expf(x0 - m), e1 = __expf(x1 - m), e2 = __expf(x2 - m), e3 = __expf(x3 - m);
        const float inv = 1.0f / (e0 + e1 + e2 + e3);
        float lb = 0.f;
        if (l >= 1) lb += e1; if (l >= 2) lb += e2; if (l >= 3) lb += e3;
        sm[L_LB2 + tid] = lb * inv;
    }
    for (int i = tid; i < (L_SB - L_KT); i += 512) ((LAS unsigned*)(sm + L_KT))[i] = 0u;
    f32x4 S[4];
    {
        const float* Lb = Lm + (size_t)((seg > 0 ? seg - 1 : 0) * 4 + h) * V * K;
#pragma unroll
        for (int n = 0; n < 4; ++n) S[n] = (seg > 0) ? *(const f32x4*)(Lb + (size_t)(16 * n + row) * K + 16 * wave + 4 * q) : (f32x4){0.f, 0.f, 0.f, 0.f};
#pragma unroll
        for (int n = 0; n < 4; ++n) { u32x2 w; w.x = pk2(S[n][0], S[n][1]); w.y = pk2(S[n][2], S[n][3]); *(LAS u32x2*)(Sb + (16 * n + row) * SP + 16 * wave + 4 * q) = w; }
    }
    DG_LOAD(0);
    lds_barrier();
    DG_STORE(0); DG_LOAD(1);
    lds_barrier();
    for (int sb = 0; sb < SEG / TS; ++sb) {
        const int cur = sb & 1;
        const LAS float* bf = sm + cur * 7680;
        LAS float* ob = sm + 15360 + cur * 1536;
        bf16_t pf_g1[2];
#pragma unroll
        for (int rr = 0; rr < 2; ++rr) { const int tok = seg * SEG + sb * TS + wave + 8 * rr; pf_g1[rr] = PH[(size_t)tok * PHG + 1280 + h * 64 + lane]; }
        if (tid < 256) {
            const int j = tid >> 4, sl = tid & 15;
            f32x4 z0 = *(const LAS f32x4*)(bf + 4096 + j * K + 8 * sl), z1 = *(const LAS f32x4*)(bf + 4096 + j * K + 8 * sl + 4);
            f32x4 na0 = *(const LAS f32x4*)(bf + j * K + 8 * sl), na1 = *(const LAS f32x4*)(bf + j * K + 8 * sl + 4);
            const int tj1 = (j + 1 < TS) ? j + 1 : j;
            f32x4 nd0 = *(const LAS f32x4*)(bf + 2048 + tj1 * K + 8 * sl), nd1 = *(const LAS f32x4*)(bf + 2048 + tj1 * K + 8 * sl + 4);
            for (int t = j; t < TS; ++t) {
                const f32x4 a0 = na0, a1 = na1, d0 = nd0, d1 = nd1;
                { const int tn = (t + 1 < TS) ? t + 1 : t, tn2 = (t + 2 < TS) ? t + 2 : TS - 1;
                  na0 = *(const LAS f32x4*)(bf + tn * K + 8 * sl); na1 = *(const LAS f32x4*)(bf + tn * K + 8 * sl + 4);
                  nd0 = *(const LAS f32x4*)(bf + 2048 + tn2 * K + 8 * sl); nd1 = *(const LAS f32x4*)(bf + 2048 + tn2 * K + 8 * sl + 4); }
                part[(t * 16 + j) * 20 + sl] = (a0.x * z0.x + a0.y * z0.y) + (a0.z * z0.z + a0.w * z0.w) + (a1.x * z1.x + a1.y * z1.y) + (a1.z * z1.z + a1.w * z1.w);
                z0 = z0 * d0; z1 = z1 * d1;
            }
        } else if (tid < 384) {
            const int c = tid - 256;
            float dd[TS], qq[TS], kk_[TS];
#pragma unroll
            for (int t = 0; t < TS; ++t) { dd[t] = bf[2048 + t * K + c]; qq[t] = bf[t * K + c]; kk_[t] = bf[4096 + t * K + c]; }
            float G = 1.0f;
#pragma unroll
            for (int t = 0; t < TS; ++t) { G *= dd[t]; qG[t * QP + c] = f2bf(qq[t] * G); }
            G15[c] = G;
            float H = 1.0f;
#pragma unroll
            for (int t = TS - 1; t >= 0; --t) { kT[c * TP + t] = f2bf(kk_[t] * H); H *= dd[t]; }
        } else {
            float vv_[8];
#pragma unroll
            for (int e = 0; e < 8; ++e) vv_[e] = bf[6144 + (tid - 384) + 128 * e];
#pragma unroll
            for (int e = 0; e < 8; ++e) { const int idx = (tid - 384) + 128 * e; vT[(idx & 63) * TP + (idx >> 6)] = f2bf(vv_[e]); }
        }
        lds_barrier();
        if (tid < 256) {
            const int t = tid >> 4, j = tid & 15;
            float a = 0.f;
            if (j <= t) {
                const LAS f32x4* pp = (const LAS f32x4*)(part + (t * 16 + j) * 20);
                const f32x4 x0 = pp[0], x1 = pp[1], x2 = pp[2], x3 = pp[3];
                a = ((x0.x + x0.y) + (x0.z + x0.w)) + ((x1.x + x1.y) + (x1.z + x1.w)) + ((x2.x + x2.y) + (x2.z + x2.w)) + ((x3.x + x3.y) + (x3.z + x3.w));
            }
            Am[t * TP + j] = f2bf(a);
        }
        lds_barrier();
        if (wave < 4) {
            f32x4 o = {0.f, 0.f, 0.f, 0.f};
#pragma unroll
            for (int kc = 0; kc < 4; ++kc)
                o = __builtin_amdgcn_mfma_f32_16x16x32_bf16(*(const LAS pg8::bf16x8*)(qG + row * QP + 32 * kc + 8 * q), *(const LAS pg8::bf16x8*)(Sb + (16 * wave + row) * SP + 32 * kc + 8 * q), o, 0, 0, 0);
            o = __builtin_amdgcn_mfma_f32_16x16x32_bf16(*(const LAS pg8::bf16x8*)(Am + row * TP + 8 * q), *(const LAS pg8::bf16x8*)(vT + (16 * wave + row) * TP + 8 * q), o, 0, 0, 0);
#pragma unroll
            for (int i = 0; i < 4; ++i) ob[(4 * q + i) * 64 + 16 * wave + row] = o[i];
        }
        {
            const f32x4 gg = *(const LAS f32x4*)(G15 + 16 * wave + 4 * q);
            const pg8::bf16x8 a = *(const LAS pg8::bf16x8*)(kT + (16 * wave + row) * TP + 8 * q);
#pragma unroll
            for (int n = 0; n < 4; ++n) S[n] = __builtin_amdgcn_mfma_f32_16x16x32_bf16(a, *(const LAS pg8::bf16x8*)(vT + (16 * n + row) * TP + 8 * q), S[n] * gg, 0, 0, 0);
        }
        lds_barrier();
#pragma unroll
        for (int n = 0; n < 4; ++n) { u32x2 w; w.x = pk2(S[n][0], S[n][1]); w.y = pk2(S[n][2], S[n][3]); *(LAS u32x2*)(Sb + (16 * n + row) * SP + 16 * wave + 4 * q) = w; }
#pragma unroll
        for (int rr = 0; rr < 2; ++rr) {
            const int t = wave + 8 * rr, tok = seg * SEG + sb * TS + t;
            const float y = ob[t * 64 + lane];
            const float ms = wave_sum(y * y) * (1.0f / 64.0f);
            const float yn = y * rsqrtf(ms + 1e-5f);
            MX[(size_t)tok * D + 384 + h * 64 + lane] = f2bf(yn * gn1 * silu(bf2f(pf_g1[rr])));
        }
        if (sb + 1 < SEG / TS) DG_STORE(cur ^ 1);
        if (sb + 2 < SEG / TS) DG_LOAD(sb + 2);
        lds_barrier();
    }
}

__device__ __forceinline__ void gl_item_C(const Params& p, int l, int seg, int h, LAS float* sm, int tid, int lane, int wave) {
    constexpr bool HG = false; constexpr int pass = 1;
    constexpr int K = 48, V = 96;
    constexpr int NQK = TS * K, NV = TS * V, EQ = (NQK + 511) / 512, EV = (NV + 511) / 512;
    constexpr int L_LB2 = 18432, L_GUP = 18560, L_CW = 19328, L_GB = 20096;
    constexpr int L_QG = 20480, L_KT = 21056, L_VT = 22016, L_AM = 23936, L_SB = 24256, L_G15 = 27712, L_PART = 27776;
    constexpr int QP = 72, SP = 72;
    (void)L_LB2;
    unsigned char* ws = p.ws();
    const bf16_t* PH = (const bf16_t*)(ws + WS_PHG); const bf16_t* PG = (const bf16_t*)(ws + WS_PGL);
    const float* Lm = (const float*)(ws + WS_GLL);
    bf16_t* MX = (bf16_t*)(ws + WS_H);
    LAS bf16_t* qG = (LAS bf16_t*)(sm + L_QG); LAS bf16_t* kT = (LAS bf16_t*)(sm + L_KT); LAS bf16_t* vT = (LAS bf16_t*)(sm + L_VT);
    LAS bf16_t* Am = (LAS bf16_t*)(sm + L_AM); LAS bf16_t* Sb = (LAS bf16_t*)(sm + L_SB);
    LAS float* G15 = sm + L_G15; LAS float* part = sm + L_PART;
    bf16_t rf[EQ], rq[EQ], rv[EV];
    bf16_t cq[EQ][4], ck[EQ][4], cv[EV][4];
    u32x4 g0[EQ], g1[EQ];
    const int row = lane & 15, q = lane >> 4;
    const float gn1 = p.in(28)[l * 384 + h * 96 + lane], gn2 = lane < 32 ? p.in(28)[l * 384 + h * 96 + 64 + lane] : 0.f;
    lds_barrier();
    {
        const float* cw = p.in(25) + (size_t)l * 4 * 768;
        for (int i = tid; i < 768; i += 512) { const int r = i / 48, c = i % 48; sm[L_GUP + i] = p.in(26)[(size_t)l * 16 * 192 + r * 192 + h * 48 + c]; }
        for (int i = tid; i < 768; i += 512) { const int jj = i / 192, c = i % 192; const int ch = c < 48 ? h * 48 + c : (c < 96 ? 192 + h * 48 + (c - 48) : 384 + h * 96 + (c - 96)); sm[L_CW + i] = cw[jj * 768 + ch]; }
        if (tid < 48) sm[L_GB + tid] = p.in(27)[l * 192 + h * 48 + tid];
    }
    for (int i = tid; i < (L_G15 - L_QG); i += 512) ((LAS unsigned*)(sm + L_QG))[i] = 0u;
    lds_barrier();
    f32x4 S[3];
#pragma unroll
    for (int m = 0; m < 3; ++m) S[m] = (f32x4){0.f, 0.f, 0.f, 0.f};
    if (wave < 6) {
        const float* Lb = Lm + (size_t)((seg > 0 ? seg - 1 : 0) * 4 + h) * V * K;
        if (seg > 0) {
#pragma unroll
            for (int m = 0; m < 3; ++m) S[m] = *(const f32x4*)(Lb + (size_t)(16 * wave + row) * K + 16 * m + 4 * q);
        }
#pragma unroll
        for (int m = 0; m < 3; ++m) { u32x2 w; w.x = pk2(S[m][0], S[m][1]); w.y = pk2(S[m][2], S[m][3]); *(LAS u32x2*)(Sb + (16 * wave + row) * SP + 16 * m + 4 * q) = w; }
    }
    DG_LOAD(0);
    lds_barrier();
    DG_STORE(0); DG_LOAD(1);
    lds_barrier();
    for (int sb = 0; sb < SEG / TS; ++sb) {
        const int cur = sb & 1;
        const LAS float* bf = sm + cur * 7680;
        LAS float* ob = sm + 15360 + cur * 1536;
        bf16_t pf_g1[2], pf_g2[2];
#pragma unroll
        for (int rr = 0; rr < 2; ++rr) { const int tok = seg * SEG + sb * TS + wave + 8 * rr; const bf16_t* rowp = PG + (size_t)tok * PGL + 784 + h * 96; pf_g1[rr] = rowp[lane]; pf_g2[rr] = lane < 32 ? rowp[64 + lane] : (bf16_t)0; }
        if (tid < 256) {
            const int j = tid >> 4, sl = tid & 15;
            float z0 = bf[4096 + j * K + 3 * sl], z1 = bf[4096 + j * K + 3 * sl + 1], z2 = bf[4096 + j * K + 3 * sl + 2];
            float nq0 = bf[j * K + 3 * sl], nq1 = bf[j * K + 3 * sl + 1], nq2 = bf[j * K + 3 * sl + 2];
            const int tj1 = (j + 1 < TS) ? j + 1 : j;
            float nd0 = bf[2048 + tj1 * K + 3 * sl], nd1 = bf[2048 + tj1 * K + 3 * sl + 1], nd2 = bf[2048 + tj1 * K + 3 * sl + 2];
            for (int t = j; t < TS; ++t) {
                const float q0 = nq0, q1 = nq1, q2 = nq2, d0 = nd0, d1 = nd1, d2 = nd2;
                { const int tn = (t + 1 < TS) ? t + 1 : t, tn2 = (t + 2 < TS) ? t + 2 : TS - 1;
                  const LAS float* qp = bf + tn * K + 3 * sl; nq0 = qp[0]; nq1 = qp[1]; nq2 = qp[2];
                  const LAS float* dp = bf + 2048 + tn2 * K + 3 * sl; nd0 = dp[0]; nd1 = dp[1]; nd2 = dp[2]; }
                part[(t * 16 + j) * 20 + sl] = q0 * z0 + q1 * z1 + q2 * z2;
                z0 *= d0; z1 *= d1; z2 *= d2;
            }
        } else if (tid < 256 + K) {
            const int c = tid - 256;
            float dd[TS], qq[TS], kk_[TS];
#pragma unroll
            for (int t = 0; t < TS; ++t) { dd[t] = bf[2048 + t * K + c]; qq[t] = bf[t * K + c]; kk_[t] = bf[4096 + t * K + c]; }
            float G = 1.0f;
#pragma unroll
            for (int t = 0; t < TS; ++t) { G *= dd[t]; qG[t * QP + c] = f2bf(qq[t] * G); }
            G15[c] = G;
            float H = 1.0f;
#pragma unroll
            for (int t = TS - 1; t >= 0; --t) { kT[c * TP + t] = f2bf(kk_[t] * H); H *= dd[t]; }
        } else if (tid >= 384) {
            float vv_[12];
#pragma unroll
            for (int e = 0; e < 12; ++e) vv_[e] = bf[6144 + (tid - 384) + 128 * e];
#pragma unroll
            for (int e = 0; e < 12; ++e) { const int idx = (tid - 384) + 128 * e; vT[(idx % V) * TP + (idx / V)] = f2bf(vv_[e]); }
        }
        lds_barrier();
        if (tid < 256) {
            const int t = tid >> 4, j = tid & 15;
            float a = 0.f;
            if (j <= t) {
                const LAS f32x4* pp = (const LAS f32x4*)(part + (t * 16 + j) * 20);
                const f32x4 x0 = pp[0], x1 = pp[1], x2 = pp[2], x3 = pp[3];
                a = ((x0.x + x0.y) + (x0.z + x0.w)) + ((x1.x + x1.y) + (x1.z + x1.w)) + ((x2.x + x2.y) + (x2.z + x2.w)) + ((x3.x + x3.y) + (x3.z + x3.w));
            }
            Am[t * TP + j] = f2bf(a);
        }
        lds_barrier();
        if (wave < 6) {
            f32x4 o = {0.f, 0.f, 0.f, 0.f};
#pragma unroll
            for (int kc = 0; kc < 2; ++kc)
                o = __builtin_amdgcn_mfma_f32_16x16x32_bf16(*(const LAS pg8::bf16x8*)(qG + row * QP + 32 * kc + 8 * q), *(const LAS pg8::bf16x8*)(Sb + (16 * wave + row) * SP + 32 * kc + 8 * q), o, 0, 0, 0);
            const pg8::bf16x8 vb = *(const LAS pg8::bf16x8*)(vT + (16 * wave + row) * TP + 8 * q);
            o = __builtin_amdgcn_mfma_f32_16x16x32_bf16(*(const LAS pg8::bf16x8*)(Am + row * TP + 8 * q), vb, o, 0, 0, 0);
#pragma unroll
            for (int i = 0; i < 4; ++i) ob[(4 * q + i) * 96 + 16 * wave + row] = o[i];
#pragma unroll
            for (int m = 0; m < 3; ++m) {
                const f32x4 gg = *(const LAS f32x4*)(G15 + 16 * m + 4 * q);
                S[m] = __builtin_amdgcn_mfma_f32_16x16x32_bf16(*(const LAS pg8::bf16x8*)(kT + (16 * m + row) * TP + 8 * q), vb, S[m] * gg, 0, 0, 0);
            }
        }
        lds_barrier();
        if (wave < 6) {
#pragma unroll
            for (int m = 0; m < 3; ++m) { u32x2 w; w.x = pk2(S[m][0], S[m][1]); w.y = pk2(S[m][2], S[m][3]); *(LAS u32x2*)(Sb + (16 * wave + row) * SP + 16 * m + 4 * q) = w; }
        }
#pragma unroll
        for (int rr = 0; rr < 2; ++rr) {
            const int t = wave + 8 * rr, tok = seg * SEG + sb * TS + t;
            const float y1 = ob[t * 96 + lane];
            const float y2 = lane < 32 ? ob[t * 96 + 64 + lane] : 0.f;
            const float ms = wave_sum(y1 * y1 + y2 * y2) * (1.0f / 96.0f);
            const float rs = rsqrtf(ms + 1e-5f);
            bf16_t* mo = MX + (size_t)tok * D + 640 + h * 96;
            mo[lane] = f2bf(y1 * rs * gn1 * silu(bf2f(pf_g1[rr])));
            if (lane < 32) mo[64 + lane] = f2bf(y2 * rs * gn2 * silu(bf2f(pf_g2[rr])));
        }
        if (sb + 1 < SEG / TS) DG_STORE(cur ^ 1);
        if (sb + 2 < SEG / TS) DG_LOAD(sb + 2);
        lds_barrier();
    }
}
#undef DG_LOAD
#undef DG_STORE

template <int pass>
__device__ __forceinline__ void phase_scan(const Params& p, int l, LAS unsigned char* lds, int tid, int lane, int wave) {
    LAS float* sm = (LAS float*)lds;
    constexpr int N_RW = NSEG * 6, N_HG = NSEG * 4, N_GL = NSEG * 4;
    for (int it = blockIdx.x; it < N_RW + N_HG + N_GL; it += gridDim.x) {
        asm volatile("" : "+v"(tid));
        lane = tid & 63; wave = __builtin_amdgcn_readfirstlane(tid >> 6);
        if (it < N_RW) rw_item<pass>(p, l, it / 6, it % 6, sm, tid, lane, wave);
        else if (it < N_RW + N_HG) { if constexpr (pass == 0) diag_item_A<true>(p, l, (it - N_RW) / 4, (it - N_RW) % 4, sm, tid, lane, wave); else hg_item_C(p, l, (it - N_RW) / 4, (it - N_RW) % 4, sm, tid, lane, wave); }
        else { if constexpr (pass == 0) diag_item_A<false>(p, l, (it - N_RW - N_HG) / 4, (it - N_RW - N_HG) % 4, sm, tid, lane, wave); else gl_item_C(p, l, (it - N_RW - N_HG) / 4, (it - N_RW - N_HG) % 4, sm, tid, lane, wave); }
    }
}

__device__ __forceinline__ void phase_combine(const Params& p, LAS unsigned char* lds, int tid, int lane, int wave, bool dummy) {
    unsigned char* ws = p.ws();
    for (int b = blockIdx.x; b < 124; b += gridDim.x) {
        if (b < 24) {
            const int head = b >> 2, nt = b & 3, row = lane & 15, q = lane >> 4;
            float* Lm = (float*)(ws + WS_RWL); const float* Pm = (const float*)(ws + WS_RWP);
            LAS float* buf = (LAS float*)lds;
            LAS float* sbuf = buf + 8192;
            constexpr size_t SS = 6 * 4096;
            const float* pbase = Pm + (size_t)head * 4096 + tid * 8;
            const int wv = wave & 3;
            float* lbase = Lm + ((size_t)head * 64 + 16 * nt + row) * 64 + 16 * wv + 4 * q;
            float* sbase = (dummy ? (float*)(ws + WS_H) : Lm) + ((size_t)head * 64 + 16 * nt + row) * 64 + 16 * wv + 4 * q;
            f32x4 pr[6][2]; f32x4 lq[6];
            lds_barrier();
            { const f32x4* qq = (const f32x4*)pbase; const f32x4 a = qq[0], c = qq[1]; *(LAS f32x4*)(buf + tid * 8) = a; *(LAS f32x4*)(buf + tid * 8 + 4) = c; }
            for (int i = tid; i < 2048; i += 512) sbuf[i] = 0.f;
#pragma unroll
            for (int u = 0; u < 6; ++u) {
                const f32x4* qq = (const f32x4*)(pbase + (size_t)(1 + u) * SS); pr[u][0] = qq[0]; pr[u][1] = qq[1];
                lq[u] = *(const f32x4*)(lbase + (size_t)u * SS);
            }
            lds_barrier();
#define CB_STEP(seg, u, REFILL) do { \
                LAS float* wb = buf + (((seg) + 1) & 1) * 4096 + tid * 8; \
                *(LAS f32x4*)wb = pr[u][0]; *(LAS f32x4*)(wb + 4) = pr[u][1]; \
                f32x4 acc = lq[u]; \
                if (REFILL) { const int sn = ((seg) + 7 < NSEG - 1) ? (seg) + 7 : NSEG - 2; const f32x4* qq = (const f32x4*)(pbase + (size_t)sn * SS); pr[u][0] = qq[0]; pr[u][1] = qq[1]; \
                  const int ln = ((seg) + 6 < NSEG - 1) ? (seg) + 6 : NSEG - 2; lq[u] = *(const f32x4*)(lbase + (size_t)ln * SS); } \
                if (wave < 4) { \
                    const LAS float* pa = buf + ((seg) & 1) * 4096 + q * 64 + 16 * wv + row;        \
                    const LAS float* pb = sbuf + ((seg) & 1) * 1024 + q * 16 + row;                 \
                    float av_[16], bv_[16]; \
                    _Pragma("unroll") for (int s_ = 0; s_ < 16; ++s_) { av_[s_] = pa[s_ * 256]; bv_[s_] = pb[s_ * 64]; } \
                    asm volatile("s_waitcnt lgkmcnt(0)" ::: "memory");        \
                    f32x4 acc2 = {0.f, 0.f, 0.f, 0.f}; \
                    _Pragma("unroll") for (int s_ = 0; s_ < 16; s_ += 2) { acc = __builtin_amdgcn_mfma_f32_16x16x4f32(av_[s_], bv_[s_], acc, 0, 0, 0); acc2 = __builtin_amdgcn_mfma_f32_16x16x4f32(av_[s_ + 1], bv_[s_ + 1], acc2, 0, 0, 0); } \
                    acc = acc + acc2; \
                    *(f32x4*)(sbase + (size_t)(seg) * SS) = acc; \
                    LAS float* sw = sbuf + (((seg) + 1) & 1) * 1024 + (16 * wv + 4 * q) * 16 + row; \
                    sw[0] = acc[0]; sw[16] = acc[1]; sw[32] = acc[2]; sw[48] = acc[3]; \
                } \
                lds_barrier(); } while (0)
            for (int seg0 = 0; seg0 < 126; seg0 += 6) {
                CB_STEP(seg0 + 0, 0, true); CB_STEP(seg0 + 1, 1, true); CB_STEP(seg0 + 2, 2, true);
                CB_STEP(seg0 + 3, 3, true); CB_STEP(seg0 + 4, 4, true); CB_STEP(seg0 + 5, 5, true);
            }
            CB_STEP(126, 0, false);
#undef CB_STEP
            static_assert(NSEG == 128, "combine schedule");
        } else {
            int e = (b - 24) * 512 + tid;
            float* Lm; const float* Dm; size_t lstride, dstride; size_t lo, dof;
            if (e < 4 * 8192) { const int h = e / 8192, rem = e % 8192, c = rem % 128; Lm = (float*)(ws + WS_HGL); Dm = (const float*)(ws + WS_HGD); lstride = 4 * 8192; dstride = 4 * 128; lo = (size_t)h * 8192 + rem; dof = (size_t)h * 128 + c; }
            else { e -= 4 * 8192; const int h = e / 4608, rem = e % 4608, c = rem % 48; Lm = (float*)(ws + WS_GLL); Dm = (const float*)(ws + WS_GLD); lstride = 4 * 4608; dstride = 4 * 48; lo = (size_t)h * 4608 + rem; dof = (size_t)h * 48 + c; }
            float s = 0.f;
            float* Ls = Lm;
            if (dummy) { if (e >= 0 && Lm == (float*)(ws + WS_HGL)) Ls = (float*)(ws + WS_H) + 3145728; else continue; }
            for (int s0 = 0; s0 < NSEG - 1; s0 += 32) {
                float lv[32], dv[32];
#pragma unroll
                for (int i = 0; i < 32; ++i) { const int sg = (s0 + i < NSEG - 1) ? s0 + i : NSEG - 2; lv[i] = Lm[(size_t)sg * lstride + lo]; dv[i] = Dm[(size_t)sg * dstride + dof]; }
#pragma unroll
                for (int i = 0; i < 32; ++i) if (s0 + i < NSEG - 1) { s = dv[i] * s + lv[i]; Ls[(size_t)(s0 + i) * lstride + lo] = s; }
            }
        }
    }
}

#define XB_TMO      128
#define XB_XCNT(j)  (256  + 64 * (j))
#define XB_XSUB(j)  (1280 + 64 * (j))
#define XB_XGEN(j)  (2304 + 64 * (j))
#define XB_TOP      3328
#define XB_TOPGEN   3392
#define XCD_BAR_WORDS 3456
#define XB_SPIN_CAP (1u << 18)

__device__ __forceinline__ unsigned xb_ld(unsigned* p)              { return __hip_atomic_load(p, __ATOMIC_RELAXED, __HIP_MEMORY_SCOPE_AGENT); }
__device__ __forceinline__ unsigned xb_add(unsigned* p, unsigned v) { return __hip_atomic_fetch_add(p, v, __ATOMIC_RELAXED, __HIP_MEMORY_SCOPE_AGENT); }
__device__ __forceinline__ unsigned xb_xcc_id() { return (unsigned)__builtin_amdgcn_s_getreg((3 << 11) | 20) & 0xFu; }
#define XB_SPIN(cond, bar) do { unsigned _sp = 0; while (cond) { __builtin_amdgcn_s_sleep(1); \
    if ((++_sp & 255u) == 0u) { if (xb_ld(&(bar)[XB_TMO])) break; if (_sp > XB_SPIN_CAP) { atomicAdd(&(bar)[XB_TMO], 1u); break; } } } } while (0)

struct XcdBarrier {
    unsigned* bar; unsigned x;
    volatile LAS unsigned* st;
};

__device__ __forceinline__ XcdBarrier xcd_barrier_post(unsigned* bar, volatile LAS unsigned* st) {
    XcdBarrier b; b.bar = bar; b.x = xb_xcc_id(); b.st = st;
    if (threadIdx.x == 0) (void)xb_add(&bar[XB_XCNT(b.x)], 1u);
    return b;
}
__device__ __forceinline__ void xcd_barrier_complete(unsigned* bar, unsigned x, unsigned& nloc, unsigned& nx) {
    const unsigned G = gridDim.x * gridDim.y * gridDim.z;
    unsigned sum, cnt, mine, sp = 0u;
    for (;;) {
        sum = 0u; cnt = 0u; mine = 0u;
#pragma unroll
        for (unsigned j = 0; j < 16; ++j) { const unsigned c = xb_ld(&bar[XB_XCNT(j)]); sum += c; cnt += (c > 0u) ? 1u : 0u; mine = (j == x) ? c : mine; }
        if (sum == G) break;
        __builtin_amdgcn_s_sleep(1);
        if ((++sp & 255u) == 0u) { if (xb_ld(&bar[XB_TMO])) break; if (sp > XB_SPIN_CAP) { atomicAdd(&bar[XB_TMO], 1u); break; } }
    }
    nloc = mine > 0u ? mine : 1u; nx = cnt > 0u ? cnt : 1u;
}

__device__ __forceinline__ void xcd_barrier(const XcdBarrier& b) {
    asm volatile("s_waitcnt vmcnt(0)" ::: "memory");
    __syncthreads();
    if (threadIdx.x == 0) {
        unsigned* bar = b.bar;
        __builtin_amdgcn_s_waitcnt(0);
        unsigned nloc = b.st[0], nx = b.st[1];
        if (nloc == 0u) { xcd_barrier_complete(bar, b.x, nloc, nx); b.st[0] = nloc; b.st[1] = nx; }
        const unsigned old = xb_add(&bar[XB_XSUB(b.x)], 1u);
        const unsigned gen = old / nloc;
        if (old + 1u == (gen + 1u) * nloc) {
            __builtin_amdgcn_fence(__ATOMIC_RELEASE, "agent");
            asm volatile("s_waitcnt vmcnt(0)" ::: "memory");
            const unsigned og = xb_add(&bar[XB_TOP], 1u);
            const unsigned tg = og / nx;
            if (og + 1u == (tg + 1u) * nx) xb_add(&bar[XB_TOPGEN], 1u);
            else XB_SPIN(xb_ld(&bar[XB_TOPGEN]) == tg, bar);
            __builtin_amdgcn_fence(__ATOMIC_ACQUIRE, "agent");
            xb_add(&bar[XB_XGEN(b.x)], 1u);
            asm volatile("s_waitcnt vmcnt(0)" ::: "memory");
        } else {
            XB_SPIN(xb_ld(&bar[XB_XGEN(b.x)]) == gen, bar);
            __builtin_amdgcn_fence(__ATOMIC_ACQUIRE, "agent");
            asm volatile("s_waitcnt vmcnt(0)" ::: "memory");
        }
    }
    __syncthreads();
}

__global__ void __launch_bounds__(512, 2) mega_fwd(KArgs ka) {
    extern __shared__ __attribute__((aligned(16))) unsigned char lds_raw[];
    LAS unsigned char* lds = (LAS unsigned char*)lds_raw;
    cg::grid_group grid = cg::this_grid();
    const int G = gridDim.x, ngw = G * 8;
    if (threadIdx.x == 0) {
        LAS unsigned long long* t = (LAS unsigned long long*)(lds + TBL_OFF);
#pragma unroll
        for (int i = 0; i < 34; ++i) t[i] = (unsigned long long)ka.in[i];
        t[34] = (unsigned long long)ka.out; t[35] = (unsigned long long)ka.ws;
    }
    if (blockIdx.x == 0) { unsigned* bw = (unsigned*)(ka.ws + WS_BAR); for (int i = threadIdx.x; i < XCD_BAR_WORDS; i += 512) bw[i] = 0u; }
    if (threadIdx.x < 4) ((LAS unsigned*)(lds + TBL_OFF + 512))[threadIdx.x] = 0u;
    XcdBarrier xbar; xbar.bar = (unsigned*)(ka.ws + WS_BAR); xbar.x = 0; xbar.st = (volatile LAS unsigned*)(lds + TBL_OFF + 512);
    __syncthreads();
    Params p; p.tbl = (LAS const unsigned*)(lds + TBL_OFF);
#ifndef PROBE
#define PROBE 0
#endif
    for (int step2 = 0; step2 < 2 * (NLAYER * 13 + 1); ++step2) {
        const int step = step2 >> 1, rep = step2 & 1;
        const int l = step / 13, st = step % 13;
        {
            const bool isg = (st == 1 || st == 2 || st == 4 || st == 9 || st == 11 || st == 12), issc = (st == 6 || st == 8), isother = (st == 0 || st == 3 || st == 5 || st == 10);
            bool dorep = false;
            if ((PROBE & 1) && isg) dorep = true;
            if ((PROBE & 2) && issc) dorep = true;
            if ((PROBE & 4) && isother) dorep = true;
            if ((PROBE & 16) && st == 6) dorep = true;
            if ((PROBE & 32) && st == 8) dorep = true;
            if ((PROBE & 64) && st == 0) dorep = true;
            if ((PROBE & 128) && (st == 3 || st == 10)) dorep = true;
            if ((PROBE & 256) && st == 5) dorep = true;
            if ((PROBE & 512) && st == 7) dorep = true;
            if (step == NLAYER * 13) dorep = false;
            if (rep == 1 && !dorep) { if (PROBE & 8) { if (step != NLAYER * 13) xcd_barrier(xbar); } continue; }
        }
        const float rscale = (rep == 1) ? 0.0f : 1.0f;
        int tid = threadIdx.x; asm volatile("" : "+v"(tid));
        const int lane = tid & 63, wave = __builtin_amdgcn_readfirstlane(tid >> 6), gw = blockIdx.x * 8 + wave;
        unsigned char* ws = p.ws();
        if (step == NLAYER * 13) { if (rep == 0) phase_final_norm((const float*)(ws + WS_X), p.in(33), p.out(), gw, ngw, lane); continue; }
        if (st == 0) phase_convert(p, l, lds, gw, ngw, wave, lane);
        if (st == 0 || st == 3 || st == 10) {
            const float* src = (step == 0) ? p.in(0) : (const float*)(ws + WS_X);
            const float* gain = p.in(st == 0 ? 1 : (st == 3 ? 5 : 29)) + l * D;
            phase_norm(src, gain, (bf16_t*)(ws + WS_H), gw, ngw, lane);
        } else if (st == 1 || st == 11) {
            pg8::Gemm g{(const bf16_t*)(ws + WS_H), (const bf16_t*)(ws + (st == 1 ? WS_WUP1 : WS_WUP2)), T, 2 * FF, D};
            pg8::StaticOrder S; S.init(T, 2 * FF, G, (int)blockIdx.x);
            EpiSwiglu E{(bf16_t*)(ws + WS_ACT)};
            pg8::gemm_phase<EpiSwiglu, pg8::StaticOrder>(lds, g, S, E);
        } else if (st == 2 || st == 9 || st == 12) {
            const int K = (st == 9) ? D : FF;
            pg8::Gemm g{(const bf16_t*)(ws + (st == 9 ? WS_H : WS_ACT)), (const bf16_t*)(ws + (st == 2 ? WS_WDN1 : (st == 9 ? WS_WOUT : WS_WDN2))), T, D, K};
            pg8::StaticOrder S; S.init(T, D, G, (int)blockIdx.x);
            EpiResid E{(float*)(ws + WS_X), (step == 2 && rep == 0) ? p.in(0) : (const float*)(ws + WS_X), (st == 9 ? 1.0f : 0.5f) * rscale};
            pg8::gemm_phase<EpiResid, pg8::StaticOrder>(lds, g, S, E);
        } else if (st == 4) {
            pg8::Gemm g{(const bf16_t*)(ws + WS_H), (const bf16_t*)(ws + WS_WIN), T, NINP, D};
            pg8::StaticOrder S; S.init(T, NINP, G, (int)blockIdx.x);
            EpiProj E{(bf16_t*)(ws + WS_PRW), (bf16_t*)(ws + WS_PHG), (bf16_t*)(ws + WS_PGL)};
            pg8::gemm_phase<EpiProj, pg8::StaticOrder>(lds, g, S, E);
        } else if (st == 5) {
            phase_rwprep(p, l, lds, tid, lane, wave);
        } else if (st == 6 || st == 8) {
            if (st == 6) phase_scan<0>(p, l, lds, tid, lane, wave); else phase_scan<1>(p, l, lds, tid, lane, wave);
        } else if (st == 7) {
            phase_combine(p, lds, tid, lane, wave, rep == 1);
        }
        if (step2 == 0) { grid.sync(); xbar = xcd_barrier_post((unsigned*)(p.ws() + WS_BAR), (volatile LAS unsigned*)(lds + TBL_OFF + 512)); } else xcd_barrier(xbar);
    }
}

extern "C" void kernel_launch(void* const* d_in, const int* in_sizes, int n_in, void* d_out, int out_size, void* d_ws, size_t ws_size, hipStream_t stream) {
    static int grid = 0;
    if (grid == 0) {
        if (n_in != 34 || out_size != T * D || ws_size < WS_END) { fprintf(stderr, "kernel_launch: unexpected shapes (n_in %d, out %d, ws %zu, need %zu)\n", n_in, out_size, ws_size, (size_t)WS_END); grid = -1; return; }
        int dev = 0, cus = 0, per_cu = 0;
        if (hipGetDevice(&dev) != hipSuccess || hipDeviceGetAttribute(&cus, hipDeviceAttributeMultiprocessorCount, dev) != hipSuccess) { grid = -1; return; }
        if (hipFuncSetAttribute((const void*)mega_fwd, hipFuncAttributeMaxDynamicSharedMemorySize, LDS_BYTES) != hipSuccess) { fprintf(stderr, "kernel_launch: hipFuncSetAttribute failed\n"); grid = -1; return; }
        if (hipOccupancyMaxActiveBlocksPerMultiprocessor(&per_cu, (const void*)mega_fwd, 512, LDS_BYTES) != hipSuccess || per_cu < 1) { fprintf(stderr, "kernel_launch: occupancy query says %d\n", per_cu); per_cu = 1; }
        (void)hipGetLastError();
        grid = cus;
    }
    if (grid < 0) return;
    KArgs a{};
    for (int i = 0; i < 34; ++i) a.in[i] = (const float*)d_in[i];
    a.out = (float*)d_out; a.ws = (unsigned char*)d_ws;
    void* args[] = {&a};
    hipError_t e = hipLaunchCooperativeKernel((const void*)mega_fwd, dim3(grid), dim3(512), args, LDS_BYTES, stream);
    if (e != hipSuccess) fprintf(stderr, "cooperative launch failed: %s (grid %d)\n", hipGetErrorString(e), grid);
}
```
